# Optimizing an MI355X kernel written in HIP

```python
import jax, jax.numpy as jnp
from jax import lax
import numpy as np

D_MODEL = 1024
BATCH = 2
SEQ = 8192
DEPTH = 1

MEM_LEN = 256
CHUNK = 128
SG_GROUPS = 8
SG_GROUP_DIM = 64
SG_WIDTH = SG_GROUPS * SG_GROUP_DIM
MLA_HEADS = 8
MLA_NOPE = 64
MLA_ROPE = 32
MLA_V = 64
MLA_QK = MLA_NOPE + MLA_ROPE
MLA_Q_RANK = 384
MLA_KV_RANK = 256
MLA_WIDTH = MLA_HEADS * MLA_V
MEM_HEADS = 4
MEM_HEAD_DIM = 128
MEM_WIDTH = MEM_HEADS * MEM_HEAD_DIM
N_BRANCH = 3
D_FF = 2816
ROPE_BASE = 10000.0
EPS = 1e-6
Q_BLOCK = 128
NEG = -1e30

COL_U = 0
COL_V = COL_U + SG_WIDTH
COL_CQ = COL_V + SG_WIDTH
COL_CKV = COL_CQ + MLA_Q_RANK
COL_KR = COL_CKV + MLA_KV_RANK
COL_QM = COL_KR + MLA_ROPE
COL_GATE = COL_QM + MEM_WIDTH
IN_COLS = COL_GATE + N_BRANCH * D_MODEL

kernel_name = "hybrid_gated_sgu_mla_memxattn_macaron"


def rmsnorm(x, g):
    xf = x.astype(jnp.float32)
    y = xf * lax.rsqrt(jnp.mean(xf * xf, axis=-1, keepdims=True) + EPS)
    return (y * g.astype(jnp.float32)).astype(x.dtype)


def layernorm(x, g, b):
    xf = x.astype(jnp.float32)
    mu = jnp.mean(xf, axis=-1, keepdims=True)
    xc = xf - mu
    y = xc * lax.rsqrt(jnp.mean(xc * xc, axis=-1, keepdims=True) + EPS)
    return (y * g.astype(jnp.float32) + b.astype(jnp.float32)).astype(x.dtype)


def rope(x, positions):
    half = x.shape[-1] // 2
    inv = ROPE_BASE ** (-jnp.arange(half, dtype=jnp.float32) / half)
    ang = positions.astype(jnp.float32)[:, :, None] * inv
    cos = jnp.cos(ang)[:, :, None, :]
    sin = jnp.sin(ang)[:, :, None, :]
    x1 = x[..., :half].astype(jnp.float32)
    x2 = x[..., half:].astype(jnp.float32)
    return jnp.concatenate([x1 * cos - x2 * sin, x2 * cos + x1 * sin], axis=-1).astype(x.dtype)


def swiglu(x, w_gu, w_down):
    g, u = jnp.split(x @ w_gu, 2, axis=-1)
    return (jax.nn.silu(g) * u) @ w_down


def spatial_gating(u, v, ln_g, ln_b, w_s, b_s):
    B, S, _ = v.shape
    nc = S // CHUNK
    v = layernorm(v, ln_g, ln_b).reshape(B, nc, CHUNK, SG_GROUPS, SG_GROUP_DIM)
    causal = jnp.tril(jnp.ones((CHUNK, CHUNK), dtype=bool))
    w = jnp.where(causal[None], w_s, jnp.zeros_like(w_s))
    mixed = jnp.einsum('gts,bcsgd->bctgd', w, v) + b_s.T[None, None, :, :, None]
    return u * mixed.reshape(B, S, SG_WIDTH)


def causal_block_attention(q, k, v):
    B, S, H, Dqk = q.shape
    Dv = v.shape[-1]
    nb = S // Q_BLOCK
    scale = Dqk ** -0.5
    qb = q.reshape(B, nb, Q_BLOCK, H, Dqk).transpose(1, 0, 2, 3, 4)
    kpos = jnp.arange(S)

    def one_block(args):
        i, qi = args
        s = jnp.einsum('bqhd,bkhd->bhqk', qi, k).astype(jnp.float32) * scale
        qpos = i * Q_BLOCK + jnp.arange(Q_BLOCK)
        mask = kpos[None, :] <= qpos[:, None]
        s = jnp.where(mask[None, None], s, NEG)
        p = jax.nn.softmax(s, axis=-1)
        return jnp.einsum('bhqk,bkhd->bqhd', p.astype(v.dtype), v)

    out = lax.map(one_block, (jnp.arange(nb), qb))
    return out.transpose(1, 0, 2, 3, 4).reshape(B, S, H * Dv)


def mla(c_q, c_kv, k_rope, positions, cq_norm, w_uq, ckv_norm, w_ukv, q_norm, k_norm):
    B, S, _ = c_q.shape
    q = (rmsnorm(c_q, cq_norm) @ w_uq).reshape(B, S, MLA_HEADS, MLA_QK)
    q = rmsnorm(q, q_norm)
    q = jnp.concatenate([q[..., :MLA_NOPE], rope(q[..., MLA_NOPE:], positions)], axis=-1)
    kv = (rmsnorm(c_kv, ckv_norm) @ w_ukv).reshape(B, S, MLA_HEADS, MLA_NOPE + MLA_V)
    k_nope, v = kv[..., :MLA_NOPE], kv[..., MLA_NOPE:]
    k_pe = jnp.broadcast_to(k_rope[:, :, None, :], (B, S, MLA_HEADS, MLA_ROPE))
    k = rmsnorm(jnp.concatenate([k_nope, k_pe], axis=-1), k_norm)
    k = jnp.concatenate([k[..., :MLA_NOPE], rope(k[..., MLA_NOPE:], positions)], axis=-1)
    return causal_block_attention(q, k, v)


def memory_attention(q_m, mem, mem_norm, w_kv, q_norm, k_norm):
    B, S, _ = q_m.shape
    q = rmsnorm(q_m.reshape(B, S, MEM_HEADS, MEM_HEAD_DIM), q_norm)
    kv = rmsnorm(mem, mem_norm) @ w_kv
    M = mem.shape[1]
    k = rmsnorm(kv[..., :MEM_WIDTH].reshape(B, M, MEM_HEADS, MEM_HEAD_DIM), k_norm)
    v = kv[..., MEM_WIDTH:].reshape(B, M, MEM_HEADS, MEM_HEAD_DIM)
    s = jnp.einsum('bshd,bmhd->bhsm', q, k).astype(jnp.float32) * (MEM_HEAD_DIM ** -0.5)
    p = jax.nn.softmax(s, axis=-1)
    return jnp.einsum('bhsm,bmhd->bshd', p.astype(v.dtype), v).reshape(B, S, MEM_WIDTH)


def setup_inputs(seed: int = 0) -> dict:
    key = jax.random.key(seed)
    ks = iter(jax.random.split(key, 40))

    def nrm(shape, scale):
        return jax.random.normal(next(ks), shape, jnp.float32) * scale

    def gain(n):
        return 1.0 + nrm((DEPTH, n), 0.05)

    L = DEPTH
    d = D_MODEL
    x = nrm((BATCH, SEQ, d), 1.0)
    mem = nrm((BATCH, MEM_LEN, d), 1.0)
    offset = jax.random.randint(next(ks), (BATCH, 1), 0, 1024, dtype=jnp.int32)
    positions = offset + jnp.arange(SEQ, dtype=jnp.int32)[None, :]
    return {
        "x": x,
        "mem": mem,
        "positions": positions,
        "ffn1_norm": gain(d),
        "ffn1_w_gu": nrm((L, d, 2 * D_FF), d ** -0.5),
        "ffn1_w_down": nrm((L, D_FF, d), D_FF ** -0.5),
        "mix_norm": gain(d),
        "w_in": nrm((L, d, IN_COLS), d ** -0.5),
        "b_gate": nrm((L, N_BRANCH * d), 0.02),
        "sg_ln_g": gain(SG_WIDTH),
        "sg_ln_b": nrm((L, SG_WIDTH), 0.02),
        "sg_w": nrm((L, SG_GROUPS, CHUNK, CHUNK), 0.5 * CHUNK ** -0.5),
        "sg_b": 1.0 + nrm((L, SG_GROUPS, CHUNK), 0.1),
        "mla_cq_norm": gain(MLA_Q_RANK),
        "mla_w_uq": nrm((L, MLA_Q_RANK, MLA_HEADS * MLA_QK), MLA_Q_RANK ** -0.5),
        "mla_ckv_norm": gain(MLA_KV_RANK),
        "mla_w_ukv": nrm((L, MLA_KV_RANK, MLA_HEADS * (MLA_NOPE + MLA_V)), MLA_KV_RANK ** -0.5),
        "mla_q_norm": gain(MLA_QK),
        "mla_k_norm": gain(MLA_QK),
        "mem_norm": gain(d),
        "mem_w_kv": nrm((L, d, 2 * MEM_WIDTH), d ** -0.5),
        "mem_q_norm": gain(MEM_HEAD_DIM),
        "mem_k_norm": gain(MEM_HEAD_DIM),
        "w_branch_a": nrm((L, SG_WIDTH, d), SG_WIDTH ** -0.5),
        "w_branch_b": nrm((L, MLA_WIDTH, d), MLA_WIDTH ** -0.5),
        "w_branch_c": nrm((L, MEM_WIDTH, d), MEM_WIDTH ** -0.5),
        "w_out": nrm((L, d, d), d ** -0.5),
        "ffn2_norm": gain(d),
        "ffn2_w_gu": nrm((L, d, 2 * D_FF), d ** -0.5),
        "ffn2_w_down": nrm((L, D_FF, d), D_FF ** -0.5),
    }


def reference(x, mem, positions, ffn1_norm, ffn1_w_gu, ffn1_w_down, mix_norm, w_in, b_gate,
              sg_ln_g, sg_ln_b, sg_w, sg_b, mla_cq_norm, mla_w_uq, mla_ckv_norm, mla_w_ukv,
              mla_q_norm, mla_k_norm, mem_norm, mem_w_kv, mem_q_norm, mem_k_norm,
              w_branch_a, w_branch_b, w_branch_c, w_out, ffn2_norm, ffn2_w_gu, ffn2_w_down):
    B, S, _ = x.shape
    for l in range(DEPTH):
        x = x + 0.5 * swiglu(rmsnorm(x, ffn1_norm[l]), ffn1_w_gu[l], ffn1_w_down[l])
        h = rmsnorm(x, mix_norm[l])
        z = h @ w_in[l]
        u = jax.nn.gelu(z[..., COL_U:COL_V], approximate=False)
        v = jax.nn.gelu(z[..., COL_V:COL_CQ], approximate=False)
        y_a = spatial_gating(u, v, sg_ln_g[l], sg_ln_b[l], sg_w[l], sg_b[l])
        y_b = mla(z[..., COL_CQ:COL_CKV], z[..., COL_CKV:COL_KR], z[..., COL_KR:COL_QM], positions,
                  mla_cq_norm[l], mla_w_uq[l], mla_ckv_norm[l], mla_w_ukv[l],
                  mla_q_norm[l], mla_k_norm[l])
        y_c = memory_attention(z[..., COL_QM:COL_GATE], mem, mem_norm[l], mem_w_kv[l],
                               mem_q_norm[l], mem_k_norm[l])
        gates = jax.nn.sigmoid(z[..., COL_GATE:] + b_gate[l]).reshape(B, S, N_BRANCH, D_MODEL)
        merged = (gates[:, :, 0] * (y_a @ w_branch_a[l])
                  + gates[:, :, 1] * (y_b @ w_branch_b[l])
                  + gates[:, :, 2] * (y_c @ w_branch_c[l]))
        x = x + merged @ w_out[l]
        x = x + 0.5 * swiglu(rmsnorm(x, ffn2_norm[l]), ffn2_w_gu[l], ffn2_w_down[l])
    return x
```

```cpp
#include <hip/hip_runtime.h>
#include <hip/hip_cooperative_groups.h>
#include <cstdio>
#include <cstdint>
namespace cg = cooperative_groups;
namespace pg8 {
#define PG8_LAS __attribute__((address_space(3)))
typedef unsigned short bf16_t;
typedef short bf16x8 __attribute__((ext_vector_type(8)));
typedef float f32x4 __attribute__((ext_vector_type(4)));
typedef unsigned u32x4 __attribute__((ext_vector_type(4)));
constexpr int BM = 256, BK = 64, HALF = 128, HTB = HALF * BK * 2  , STAGE_BYTES = 8 * HTB, NXCD = 8, WGM = 8;

__host__ __device__ __forceinline__ int lds_byte(int r, int c) { const int st = (r >> 4) * 2 + (c >> 5), rr = r & 15, cc = c & 31, ob = rr * 64 + cc * 2; return st * 1024 + (ob ^ (((ob >> 9) & 1) << 5)); }
__host__ __device__ __forceinline__ void stage_rc(int b, int& R, int& C) { const int st = b / 1024, sb = b % 1024, swz = sb ^ (((sb >> 9) & 1) << 5); R = (st >> 1) * 16 + swz / 64; C = (st & 1) * 32 + (swz % 64) / 2; }
__host__ __device__ __forceinline__ int perm32(int rho) { const int n = rho >> 4, i = rho & 15; return 8 * (i >> 2) + 4 * n + (i & 3); }

struct Unit { int pm, pn; };
struct Gemm { const bf16_t* A; const bf16_t* Bt; int M, N, K; };

struct StaticOrder {
    int nM, nN, nwg, G, c;
    __host__ __device__ void init(int M, int N, int G_, int c_) { nM = M / BM; nN = N / BM; nwg = nM * nN; G = G_; c = c_; }
    __host__ __device__ bool next(int i, Unit& u) const {
        const long L = (long)i * G + c; if (L >= nwg) return false;
        int wgid = (int)L; { const int q = nwg / NXCD, r = nwg % NXCD, xcd = wgid % NXCD, off = wgid / NXCD; wgid = (xcd < r ? xcd * (q + 1) : r * (q + 1) + (xcd - r) * q) + off; }
        const int nig = WGM * nN, gid = wgid / nig, fm = gid * WGM, gsz = (nM - fm) < WGM ? (nM - fm) : WGM;
        u.pm = fm + ((wgid % nig) % gsz); u.pn = (wgid % nig) / gsz; return true;
    }
    __device__ __forceinline__ void a_ready(const Unit&) const {}
    __device__ __forceinline__ void done(const Unit&) const {}
};
__device__ __forceinline__ unsigned cvt_pk_bf16(float lo, float hi) { unsigned r; asm volatile("v_cvt_pk_bf16_f32 %0, %1, %2" : "=v"(r) : "v"(lo), "v"(hi)); return r; }
typedef float f32x2 __attribute__((ext_vector_type(2)));
__device__ __forceinline__ f32x2 gelu_pk(f32x2 v) {
    const f32x2 av = __builtin_elementwise_abs(v), d = av * 0.2316418882f + 1.0f;
    f32x2 t; t.x = __builtin_amdgcn_rcpf(d.x); t.y = __builtin_amdgcn_rcpf(d.y);
    f32x2 q = t * 0.5307027145f + (-0.7265760135f); q = q * t + 0.7107068705f; q = q * t + (-0.142248368f); q = q * t + 0.127414796f; q = q * t;
    const f32x2 s = (v * v) * (-0.72134752044f);
    f32x2 e; e.x = __builtin_amdgcn_exp2f(s.x); e.y = __builtin_amdgcn_exp2f(s.y);
    const f32x2 m = v * (q * e), r = v - m;
    f32x2 o; o.x = v.x < 0.f ? m.x : r.x; o.y = v.y < 0.f ? m.y : r.y; return o;
}
template <class Epi, class Sched, bool ALIGN_EPI = false, bool SP2 = false>
__device__ __forceinline__ void gemm_phase(PG8_LAS unsigned char* lds, const Gemm g, const Sched& S, const Epi& E) {
    const int tid = threadIdx.x, wid = __builtin_amdgcn_readfirstlane(tid >> 6), lane = tid & 63, wr = wid >> 2, wc = wid & 3, fr = lane & 15, fq = lane >> 4;
    const int K = g.K, nt = K / BK;
    unsigned voffA[2], voffB[2];
#pragma unroll
    for (int i = 0; i < 2; ++i) { int R, C; stage_rc(tid * 16 + i * 8192, R, C); const int Rb = Epi::PERM ? ((R & ~31) + perm32(R & 31)) : R;
        voffA[i] = (unsigned)(R * K + C) * 2u; voffB[i] = (unsigned)(Rb * K + C) * 2u; }
    const size_t kstep = (size_t)(BK * 2);
    const size_t hstep = (size_t)HALF * K * 2;
    const size_t tstep = 2 * hstep;
    const unsigned ldsw = (unsigned)wid * 1024u;
    const int aoff = lds_byte(wr * 64 + fr, fq * 8), boff = lds_byte(wc * 32 + fr, fq * 8);
#define PG8_SA(b, h) (((b) * 2 + (h)) * HTB)
#define PG8_SB(b, h) ((4 + (b) * 2 + (h)) * HTB)
#define PG8_STAGE(bufoff, gbase, voff) do { _Pragma("unroll") for (int _i = 0; _i < 2; ++_i) \
        __builtin_amdgcn_global_load_lds((const unsigned*)((const char*)(gbase) + (voff)[_i]), (PG8_LAS unsigned*)(lds + (bufoff) + ldsw + _i * 8192), 16, 0, 0); } while (0)
#define PG8_LDA(dst, b, h) do { _Pragma("unroll") for (int m = 0; m < 4; ++m) _Pragma("unroll") for (int k = 0; k < 2; ++k) dst[m][k] = *(const PG8_LAS bf16x8*)(lds + PG8_SA(b, h) + aoff + m * 2048 + k * 1024); } while (0)
#define PG8_LDB(dst, b, h) do { _Pragma("unroll") for (int n = 0; n < 2; ++n) _Pragma("unroll") for (int k = 0; k < 2; ++k) dst[n][k] = *(const PG8_LAS bf16x8*)(lds + PG8_SB(b, h) + boff + n * 2048 + k * 1024); } while (0)
#define PG8_MMA(ai, bj, At, Bt) do { __builtin_amdgcn_s_setprio(1); _Pragma("unroll") for (int m = 0; m < 4; ++m) _Pragma("unroll") for (int n = 0; n < 2; ++n) _Pragma("unroll") for (int k = 0; k < 2; ++k) \
        acc[ai][bj][m][n] = __builtin_amdgcn_mfma_f32_16x16x32_bf16(Bt[n][k], At[m][k], acc[ai][bj][m][n], 0, 0, 0); __builtin_amdgcn_s_setprio(0); } while (0)
#define PG8_WAIT_V(n) asm volatile("s_waitcnt vmcnt(" #n ")" ::: "memory")
#define PG8_WAIT_L(n) asm volatile("s_waitcnt lgkmcnt(" #n ")" ::: "memory")
#define PG8_BAR __builtin_amdgcn_s_barrier()
#define PG8_SCHED __builtin_amdgcn_sched_barrier(0)
    Unit cur, nxt; int ui = 0;
    if (!S.next(0, cur)) return;
    f32x4 acc[2][2][4][2];
#pragma unroll
    for (int a = 0; a < 2; ++a)
#pragma unroll
        for (int b = 0; b < 2; ++b)
#pragma unroll
            for (int m = 0; m < 4; ++m)
#pragma unroll
                for (int n = 0; n < 2; ++n) acc[a][b][m][n] = (f32x4){0.f, 0.f, 0.f, 0.f};
    bf16x8 At[4][2], B0[2][2], B1[2][2];
    const char* cA = (const char*)g.A + (size_t)cur.pm * tstep; const char* cB = (const char*)g.Bt + (size_t)cur.pn * tstep;
    S.a_ready(cur);
    if constexpr (SP2) {
        PG8_STAGE(PG8_SB(0, 0), cB, voffB); PG8_STAGE(PG8_SB(0, 1), cB + hstep, voffB); PG8_STAGE(PG8_SA(0, 0), cA, voffA); PG8_STAGE(PG8_SA(0, 1), cA + hstep, voffA);
        if (wr == 1) PG8_BAR;
        PG8_WAIT_V(2); PG8_BAR;
        PG8_STAGE(PG8_SB(1, 0), cB + kstep, voffB); PG8_STAGE(PG8_SA(1, 0), cA + kstep, voffA); PG8_STAGE(PG8_SB(1, 1), cB + hstep + kstep, voffB);
        PG8_WAIT_V(6); PG8_BAR;
    } else {
        PG8_STAGE(PG8_SB(0, 0), cB, voffB); PG8_STAGE(PG8_SA(0, 0), cA, voffA); PG8_STAGE(PG8_SB(0, 1), cB + hstep, voffB); PG8_STAGE(PG8_SA(0, 1), cA + hstep, voffA);
        if (wr == 1) PG8_BAR;
        PG8_WAIT_V(4); PG8_BAR;
        PG8_STAGE(PG8_SB(1, 0), cB + kstep, voffB); PG8_STAGE(PG8_SA(1, 0), cA + kstep, voffA); PG8_STAGE(PG8_SB(1, 1), cB + hstep + kstep, voffB);
        PG8_WAIT_V(6); PG8_BAR;
    }
    for (;;) {
        const bool has_next = S.next(ui + 1, nxt);
        const char* nA = has_next ? (const char*)g.A + (size_t)nxt.pm * tstep : cA; const char* nB = has_next ? (const char*)g.Bt + (size_t)nxt.pn * tstep : cB;
        for (int t = 0; t < nt; t += 2) {
            const bool last = (t == nt - 2);
            const char* a1 = cA + (size_t)(t + 1) * kstep;
            const char* a2 = last ? nA : cA + (size_t)(t + 2) * kstep; const char* b2 = last ? nB : cB + (size_t)(t + 2) * kstep;
            const char* a3 = a2 + kstep; const char* b3 = b2 + kstep;
            if (last && has_next) S.a_ready(nxt);
            if constexpr (SP2) {
            PG8_LDB(B0, 0, 0); PG8_LDB(B1, 0, 1); PG8_SCHED; PG8_LDA(At, 0, 0); PG8_STAGE(PG8_SA(1, 1), a1 + hstep, voffA);
            PG8_WAIT_V(8); PG8_WAIT_L(0); PG8_BAR; PG8_MMA(0, 0, At, B0); PG8_MMA(0, 1, At, B1); PG8_BAR; PG8_SCHED;
            PG8_LDA(At, 0, 1); PG8_STAGE(PG8_SB(0, 0), b2, voffB); PG8_STAGE(PG8_SB(0, 1), b2 + hstep, voffB); PG8_STAGE(PG8_SA(0, 0), a2, voffA);
            PG8_WAIT_V(8); PG8_WAIT_L(0); PG8_BAR; PG8_MMA(1, 0, At, B0); PG8_MMA(1, 1, At, B1); PG8_BAR; PG8_SCHED;
            PG8_LDB(B0, 1, 0); PG8_LDB(B1, 1, 1); PG8_SCHED; PG8_LDA(At, 1, 0); PG8_STAGE(PG8_SA(0, 1), a2 + hstep, voffA);
            PG8_WAIT_V(8); PG8_WAIT_L(0); PG8_BAR; PG8_MMA(0, 0, At, B0); PG8_MMA(0, 1, At, B1); PG8_BAR; PG8_SCHED;
            PG8_LDA(At, 1, 1); PG8_STAGE(PG8_SB(1, 0), b3, voffB); PG8_STAGE(PG8_SB(1, 1), b3 + hstep, voffB); PG8_STAGE(PG8_SA(1, 0), a3, voffA);
            PG8_WAIT_V(8); PG8_WAIT_L(0); PG8_BAR; PG8_MMA(1, 0, At, B0); PG8_MMA(1, 1, At, B1); PG8_BAR; PG8_SCHED;
            } else {
            PG8_LDB(B0, 0, 0); PG8_SCHED; PG8_LDA(At, 0, 0); PG8_STAGE(PG8_SA(1, 1), a1 + hstep, voffA);
            PG8_WAIT_L(8); PG8_BAR; PG8_WAIT_L(0); PG8_MMA(0, 0, At, B0); PG8_BAR; PG8_SCHED;
            PG8_LDB(B1, 0, 1); PG8_STAGE(PG8_SB(0, 0), b2, voffB);
            PG8_BAR; PG8_WAIT_L(0); PG8_MMA(0, 1, At, B1); PG8_BAR;
            PG8_LDA(At, 0, 1); PG8_STAGE(PG8_SA(0, 0), a2, voffA);
            PG8_BAR; PG8_WAIT_L(0); PG8_MMA(1, 0, At, B0); PG8_BAR; PG8_SCHED;
            PG8_STAGE(PG8_SB(0, 1), b2 + hstep, voffB);
            PG8_WAIT_V(6); PG8_BAR; PG8_MMA(1, 1, At, B1); PG8_BAR;
            PG8_LDB(B0, 1, 0); PG8_SCHED; PG8_LDA(At, 1, 0); PG8_STAGE(PG8_SA(0, 1), a2 + hstep, voffA);
            PG8_WAIT_L(8); PG8_BAR; PG8_WAIT_L(0); PG8_MMA(0, 0, At, B0); PG8_BAR; PG8_SCHED;
            PG8_LDB(B1, 1, 1); PG8_STAGE(PG8_SB(1, 0), b3, voffB);
            PG8_BAR; PG8_WAIT_L(0); PG8_MMA(0, 1, At, B1); PG8_BAR;
            PG8_LDA(At, 1, 1); PG8_STAGE(PG8_SA(1, 0), a3, voffA);
            PG8_BAR; PG8_WAIT_L(0); PG8_MMA(1, 0, At, B0); PG8_BAR; PG8_SCHED;
            PG8_STAGE(PG8_SB(1, 1), b3 + hstep, voffB);
            PG8_WAIT_V(6); PG8_BAR; PG8_MMA(1, 1, At, B1); PG8_BAR;
            }
        }
        if constexpr (ALIGN_EPI) { if (wr == 0) PG8_BAR; }
        if constexpr (!Epi::AFTER_DRAIN) { E(acc, cur, wr, wc, fr, fq); S.done(cur); }
        if (!has_next) break;
#pragma unroll
        for (int a = 0; a < 2; ++a)
#pragma unroll
            for (int b = 0; b < 2; ++b)
#pragma unroll
                for (int m = 0; m < 4; ++m)
#pragma unroll
                    for (int n = 0; n < 2; ++n) acc[a][b][m][n] = (f32x4){0.f, 0.f, 0.f, 0.f};
        cur = nxt; cA = nA; cB = nB; ++ui;
        if constexpr (ALIGN_EPI) { if (wr == 1) PG8_BAR; }
    }
    PG8_WAIT_V(0);
    if constexpr (!ALIGN_EPI) { if (wr == 0) PG8_BAR; }
    PG8_BAR;
    if constexpr (Epi::AFTER_DRAIN) { E.fused(acc, cur, wr, wc, fr, fq, lds, wid, lane); S.done(cur); }
#undef PG8_SA
#undef PG8_SB
#undef PG8_STAGE
#undef PG8_LDA
#undef PG8_LDB
#undef PG8_MMA
#undef PG8_WAIT_V
#undef PG8_WAIT_L
#undef PG8_BAR
#undef PG8_SCHED
}
}

#define DI __device__ __forceinline__
#define LAS __attribute__((address_space(3)))
using pg8::bf16_t; using pg8::f32x4; using pg8::bf16x8; using pg8::u32x4; using pg8::Unit; using pg8::f32x2;
typedef float f32x16 __attribute__((ext_vector_type(16)));
typedef short s16x4 __attribute__((ext_vector_type(4)));
typedef unsigned u32x2 __attribute__((ext_vector_type(2)));

constexpr int T = 16384, SEQ = 8192, DM = 1024, FF = 2816;
constexpr int NWIN = 2304, NGATE = 3072;
constexpr float EPS = 1e-6f;
constexpr float LOG2E = 1.4426950408889634f;
constexpr float QSCALE_MLA = 0.10206207261596575f * LOG2E;
constexpr float QSCALE_MEM = 0.08838834764831845f * LOG2E;

constexpr size_t MiB = 1u << 20;
constexpr size_t W_GU1 = 0, W_DN1 = 11 * MiB, W_IN = W_DN1 + 5632 * 1024, W_GT = W_IN + (size_t)NWIN * 2048, W_UQ = 27 * MiB + 512 * 1024, W_UKV = 28 * MiB + 512 * 1024,
                 W_MKV = 29 * MiB, W_BA = 31 * MiB, W_BB = 32 * MiB, W_BC = 33 * MiB, W_OUT = 34 * MiB, W_GU2 = 36 * MiB, W_DN2 = 47 * MiB, W_SG = 53 * MiB;
static_assert(W_GT + (size_t)NGATE * 2048 <= W_UQ && W_UQ + 768 * 384 * 2 <= W_UKV && W_DN2 + 5632 * 1024 <= W_SG, "weight map");
constexpr size_t S_SS1 = 54 * MiB, S_SS2 = 55 * MiB, S_VST = 56 * MiB, S_CQP = 58 * MiB, S_CKVP = 59 * MiB, S_QMP = 60 * MiB, S_KR = 61 * MiB,
                 S_MEMN = 63 * MiB, S_MKV = 64 * MiB, S_KM = 66 * MiB, S_VMT = 66 * MiB + 512 * 1024;
constexpr size_t S_BAR = 53 * MiB + 512 * 1024;
constexpr size_t S_R0 = 53 * MiB + 384 * 1024;
constexpr size_t S_DUMMY = 53 * MiB + 256 * 1024;
constexpr size_t BIG = 67 * MiB;
constexpr size_t B_X1B = BIG, B_MG = BIG, B_U = BIG + 32 * MiB, B_YB = BIG + 48 * MiB, B_YC = BIG + 64 * MiB, B_VG = BIG + 48 * MiB, B_CQ = BIG + 64 * MiB, B_CKV = BIG + 76 * MiB,
                 B_QM = BIG + 84 * MiB, B_QRAW = BIG + 100 * MiB, B_K = BIG + 124 * MiB, B_VT = BIG + 148 * MiB, B_KN = BIG + 164 * MiB,
                 B_G0 = BIG + 80 * MiB, B_G1 = BIG + 112 * MiB, B_G2 = BIG + 144 * MiB, B_ACT = BIG + 32 * MiB, B_XB = BIG + 120 * MiB, B_X2B = BIG + 120 * MiB;
static_assert(B_G1 - B_G0 == 32 * MiB && B_G2 - B_G1 == 32 * MiB, "gate buffers 32 MiB apart");
constexpr size_t WS_NEED = BIG + 184 * MiB;

DI unsigned f2bf(float f) { unsigned u = __builtin_bit_cast(unsigned, f); return (u + 0x7fffu + ((u >> 16) & 1u)) >> 16; }
DI unsigned pk2(float lo, float hi) { typedef float v2f __attribute__((ext_vector_type(2))); typedef __bf16 v2b __attribute__((ext_vector_type(2))); v2f v = {lo, hi}; v2b b = __builtin_convertvector(v, v2b); return __builtin_bit_cast(unsigned, b); }
DI float bflo(unsigned w) { return __uint_as_float(w << 16); }
DI float bfhi(unsigned w) { return __uint_as_float(w & 0xffff0000u); }
DI float sigmoidf_(float v) { return __builtin_amdgcn_rcpf(1.0f + __expf(-v)); }
DI float siluf_(float v) { return v * sigmoidf_(v); }

template <int NP> DI float row_rstd(const float* P, int row, float invn) {
    if (NP == 0) return 1.0f;
    return __builtin_amdgcn_rsqf(P[row] * invn + EPS);
}
DI void atomic_addf(float* p, float v) { __builtin_amdgcn_global_atomic_fadd_f32((__attribute__((address_space(1))) float*)p, v); }
DI float quad_sum(float s) { s += __shfl_xor(s, 16); s += __shfl_xor(s, 32); return s; }

template <int NP> struct EpiSwiglu {
    static constexpr bool PERM = true, AFTER_DRAIN = false;
    bf16_t* O; const float* P;
    DI void operator()(const f32x4 (&acc)[2][2][4][2], const Unit& u, int wr, int wc, int fr, int fq) const {
        const int row0 = u.pm * 256 + wr * 64 + fr, col0 = u.pn * 128 + wc * 32 + 8 * fq;
#pragma unroll
        for (int ai = 0; ai < 2; ++ai)
#pragma unroll
            for (int m = 0; m < 4; ++m) {
                const int row = row0 + ai * 128 + m * 16; const float rs = row_rstd<NP>(P, row, 1.0f / 1024.0f);
                float a[8];
#pragma unroll
                for (int n = 0; n < 2; ++n)
#pragma unroll
                    for (int i = 0; i < 4; ++i) { const float g = acc[ai][0][m][n][i] * rs, uu = acc[ai][1][m][n][i] * rs; a[4 * n + i] = siluf_(g) * uu; }
                u32x4 w; w.x = pk2(a[0], a[1]); w.y = pk2(a[2], a[3]); w.z = pk2(a[4], a[5]); w.w = pk2(a[6], a[7]);
                *(u32x4*)(O + (size_t)row * FF + col0) = w;
            }
    }
};
template <bool WB, bool B16, bool WOUT> struct EpiResid {
    static constexpr bool PERM = true, AFTER_DRAIN = false;
    const float* base  ; const bf16_t* base16; float* out; bf16_t* xb; float* P; float alpha;
    DI void operator()(const f32x4 (&acc)[2][2][4][2], const Unit& u, int wr, int wc, int fr, int fq) const {
        const int row0 = u.pm * 256 + wr * 64 + fr, col0 = u.pn * 256 + wc * 32 + 8 * fq;
#pragma unroll
        for (int ai = 0; ai < 2; ++ai)
#pragma unroll
            for (int m = 0; m < 4; ++m) {
                const int row = row0 + ai * 128 + m * 16; float ss = 0.f;
                const float bs = (B16 && base) ? base[row] : 1.0f;
#pragma unroll
                for (int bj = 0; bj < 2; ++bj) {
                    const size_t off = (size_t)row * DM + col0 + bj * 128;
                    f32x4 b0, b1;
                    if (B16) { const u32x4 bb = *(const u32x4*)(base16 + off); b0 = (f32x4){bflo(bb.x), bfhi(bb.x), bflo(bb.y), bfhi(bb.y)}; b1 = (f32x4){bflo(bb.z), bfhi(bb.z), bflo(bb.w), bfhi(bb.w)}; b0 = b0 * bs; b1 = b1 * bs; }
                    else { b0 = *(const f32x4*)(base + off); b1 = *(const f32x4*)(base + off + 4); }
                    const f32x4 o0 = b0 + acc[ai][bj][m][0] * alpha, o1 = b1 + acc[ai][bj][m][1] * alpha;
                    if (WOUT) { *(f32x4*)(out + off) = o0; *(f32x4*)(out + off + 4) = o1; }
                    if (WB) { ss += (o0[0] * o0[0] + o0[1] * o0[1]) + (o0[2] * o0[2] + o0[3] * o0[3]) + (o1[0] * o1[0] + o1[1] * o1[1]) + (o1[2] * o1[2] + o1[3] * o1[3]);
                        u32x4 w; w.x = pk2(o0[0], o0[1]); w.y = pk2(o0[2], o0[3]); w.z = pk2(o1[0], o1[1]); w.w = pk2(o1[2], o1[3]); *(u32x4*)(xb + off) = w; }
                }
                if (WB) { ss = quad_sum(ss); if (fq == 0) atomic_addf(P + row, ss); }
            }
    }
};
struct EpiWin {
    static constexpr bool PERM = true, AFTER_DRAIN = false;
    const float* P; bf16_t *U, *Vg, *CQ, *CKV, *QM; float *KR, *VST, *CQP, *CKVP, *QMP;
    DI void operator()(const f32x4 (&acc)[2][2][4][2], const Unit& u, int wr, int wc, int fr, int fq) const {
        const int row0 = u.pm * 256 + wr * 64 + fr, cw = wc * 32 + 8 * fq;
#pragma unroll
        for (int ai = 0; ai < 2; ++ai)
#pragma unroll
            for (int m = 0; m < 4; ++m) {
                const int row = row0 + ai * 128 + m * 16; const float rs = row_rstd<16>(P, row, 1.0f / 1024.0f);
#pragma unroll
                for (int bj = 0; bj < 2; ++bj) {
                    const int c128 = u.pn * 256 + bj * 128;
                    float v[8];
#pragma unroll
                    for (int n = 0; n < 2; ++n)
#pragma unroll
                        for (int i = 0; i < 4; ++i) v[4 * n + i] = acc[ai][bj][m][n][i] * rs;
                    if (c128 < 1024) {
#pragma unroll
                        for (int i = 0; i < 8; i += 2) { const f32x2 g = pg8::gelu_pk((f32x2){v[i], v[i + 1]}); v[i] = g.x; v[i + 1] = g.y; }
                        const bool isv = c128 >= 512;
                        u32x4 w; w.x = pk2(v[0], v[1]); w.y = pk2(v[2], v[3]); w.z = pk2(v[4], v[5]); w.w = pk2(v[6], v[7]);
                        *(u32x4*)((isv ? Vg : U) + (size_t)row * 512 + (c128 & 511) + cw) = w;
                        if (isv) {
                            float s1 = 0.f, s2 = 0.f;
#pragma unroll
                            for (int i = 0; i < 8; ++i) { s1 += v[i]; s2 += v[i] * v[i]; }
                            s1 = quad_sum(s1); s2 = quad_sum(s2);
                            if (fq == 0) { float* d = VST + ((size_t)row * 16 + ((c128 - 512) >> 7) * 4 + wc) * 2; d[0] = s1; d[1] = s2; }
                        }
                    } else if (c128 < 2176) {
                        bf16_t* dst; float* pp; const bool isqm = c128 >= 1664;
                        if (c128 < 1408) { dst = CQ + (size_t)row * 384 + (c128 - 1024); pp = CQP + row; }
                        else if (c128 < 1664) { dst = CKV + (size_t)row * 256 + (c128 - 1408); pp = CKVP + row; }
                        else { dst = QM + (size_t)row * 512 + (c128 - 1664); pp = QMP + (size_t)row * 16 + ((c128 - 1664) >> 7) * 4 + wc; }
                        u32x4 w; w.x = pk2(v[0], v[1]); w.y = pk2(v[2], v[3]); w.z = pk2(v[4], v[5]); w.w = pk2(v[6], v[7]);
                        *(u32x4*)(dst + cw) = w;
                        float s2 = 0.f;
#pragma unroll
                        for (int i = 0; i < 8; ++i) s2 += v[i] * v[i];
                        s2 = quad_sum(s2);
                        if (fq == 0) { if (isqm) *pp = s2; else atomic_addf(pp, s2); }
                    } else if (c128 == 2176) {
                        if (wc == 0) { float* d = KR + (size_t)row * 32 + 8 * fq; *(f32x4*)d = (f32x4){v[0], v[1], v[2], v[3]}; *(f32x4*)(d + 4) = (f32x4){v[4], v[5], v[6], v[7]}; }
                    }
                }
            }
    }
};
struct EpiGate {
    static constexpr bool PERM = true, AFTER_DRAIN = false;
    const float* P; const float* bias; bf16_t* G0;
    DI void operator()(const f32x4 (&acc)[2][2][4][2], const Unit& u, int wr, int wc, int fr, int fq) const {
        const int row0 = u.pm * 256 + wr * 64 + fr, br = u.pn >> 2, cw = (u.pn & 3) * 256 + wc * 32 + 8 * fq;
        bf16_t* G = G0 + (size_t)br * (16u << 20);
        f32x4 bv[2][2];
#pragma unroll
        for (int bj = 0; bj < 2; ++bj)
#pragma unroll
            for (int n = 0; n < 2; ++n) bv[bj][n] = *(const f32x4*)(bias + br * 1024 + cw + bj * 128 + 4 * n);
#pragma unroll
        for (int ai = 0; ai < 2; ++ai)
#pragma unroll
            for (int m = 0; m < 4; ++m) {
                const int row = row0 + ai * 128 + m * 16; const float rs = row_rstd<16>(P, row, 1.0f / 1024.0f);
#pragma unroll
                for (int bj = 0; bj < 2; ++bj) {
                    float v[8];
#pragma unroll
                    for (int n = 0; n < 2; ++n)
#pragma unroll
                        for (int i = 0; i < 4; ++i) v[4 * n + i] = sigmoidf_(acc[ai][bj][m][n][i] * rs + bv[bj][n][i]);
                    u32x4 w; w.x = pk2(v[0], v[1]); w.y = pk2(v[2], v[3]); w.z = pk2(v[4], v[5]); w.w = pk2(v[6], v[7]);
                    *(u32x4*)(G + (size_t)row * DM + cw + bj * 128) = w;
                }
            }
    }
};
struct EpiUq {
    static constexpr bool PERM = true, AFTER_DRAIN = false;
    const float* P; bf16_t* O;
    DI void operator()(const f32x4 (&acc)[2][2][4][2], const Unit& u, int wr, int wc, int fr, int fq) const {
        const int row0 = u.pm * 256 + wr * 64 + fr, cw = u.pn * 256 + wc * 32 + 8 * fq;
#pragma unroll
        for (int ai = 0; ai < 2; ++ai)
#pragma unroll
            for (int m = 0; m < 4; ++m) {
                const int row = row0 + ai * 128 + m * 16; const float rs = row_rstd<1>(P, row, 1.0f / 384.0f);
#pragma unroll
                for (int bj = 0; bj < 2; ++bj) {
                    const f32x4 a = acc[ai][bj][m][0] * rs, b = acc[ai][bj][m][1] * rs;
                    u32x4 w; w.x = pk2(a[0], a[1]); w.y = pk2(a[2], a[3]); w.z = pk2(b[0], b[1]); w.w = pk2(b[2], b[3]);
                    *(u32x4*)(O + (size_t)row * 768 + cw + bj * 128) = w;
                }
            }
    }
};
struct EpiUkv {
    static constexpr bool PERM = true, AFTER_DRAIN = false;
    const float* P; bf16_t* KN; bf16_t* Vt;
    DI void operator()(const f32x4 (&acc)[2][2][4][2], const Unit& u, int wr, int wc, int fr, int fq) const {
        const int row0 = u.pm * 256 + wr * 64 + fr;
#pragma unroll
        for (int ai = 0; ai < 2; ++ai)
#pragma unroll
            for (int m = 0; m < 4; ++m) {
                const int row = row0 + ai * 128 + m * 16; const float rs = row_rstd<1>(P, row, 1.0f / 256.0f);
                const int b = row >> 13, s = row & 8191;
#pragma unroll
                for (int bj = 0; bj < 2; ++bj) {
                    const int h = u.pn * 2 + bj;
                    const f32x4 a = acc[ai][bj][m][0] * rs, c = acc[ai][bj][m][1] * rs;
                    if (wc < 2) {
                        u32x4 w; w.x = pk2(a[0], a[1]); w.y = pk2(a[2], a[3]); w.z = pk2(c[0], c[1]); w.w = pk2(c[2], c[3]);
                        *(u32x4*)(KN + (size_t)row * 512 + h * 64 + wc * 32 + 8 * fq) = w;
                    } else {
                        const unsigned vo = (unsigned)((b * 8 + h) * 64 + (wc - 2) * 32 + 8 * fq) * (unsigned)SEQ + (unsigned)s;
#pragma unroll
                        for (int i = 0; i < 4; ++i) { Vt[vo + (unsigned)(i * SEQ)] = (bf16_t)f2bf(a[i]); Vt[vo + (unsigned)((4 + i) * SEQ)] = (bf16_t)f2bf(c[i]); }
                    }
                }
            }
    }
};
struct EpiF32 {
    static constexpr bool PERM = true, AFTER_DRAIN = false;
    float* O; int ldc;
    DI void operator()(const f32x4 (&acc)[2][2][4][2], const Unit& u, int wr, int wc, int fr, int fq) const {
        const int row0 = u.pm * 256 + wr * 64 + fr, col0 = u.pn * 256 + wc * 32 + 8 * fq;
#pragma unroll
        for (int ai = 0; ai < 2; ++ai)
#pragma unroll
            for (int m = 0; m < 4; ++m)
#pragma unroll
                for (int bj = 0; bj < 2; ++bj)
#pragma unroll
                    for (int n = 0; n < 2; ++n) *(f32x4*)(O + (size_t)(row0 + ai * 128 + m * 16) * ldc + col0 + bj * 128 + n * 4) = acc[ai][bj][m][n];
    }
};
struct BranchOrder {
    pg8::StaticOrder base;
    __device__ bool next(int i, Unit& u) const { Unit b; if (!base.next(i / 3, b)) return false; const int br = i % 3; u.pm = b.pm + 64 * br; u.pn = b.pn + 4 * br; return true; }
    DI void a_ready(const Unit&) const {}
    DI void done(const Unit&) const {}
};
struct EpiBranch {
    static constexpr bool PERM = true, AFTER_DRAIN = false;
    const bf16_t* G0; bf16_t* MG;
    DI void operator()(const f32x4 (&acc)[2][2][4][2], const Unit& u, int wr, int wc, int fr, int fq) const {
        const int br = u.pm >> 6, row0 = (u.pm & 63) * 256 + wr * 64 + fr, col0 = (u.pn & 3) * 256 + wc * 32 + 8 * fq;
        const bf16_t* G = G0 + (size_t)br * (16u << 20);
#pragma unroll
        for (int ai = 0; ai < 2; ++ai)
#pragma unroll
            for (int m = 0; m < 4; ++m)
#pragma unroll
                for (int bj = 0; bj < 2; ++bj) {
                    const size_t off = (size_t)(row0 + ai * 128 + m * 16) * DM + col0 + bj * 128;
                    const u32x4 g = *(const u32x4*)(G + off); const f32x4 a = acc[ai][bj][m][0], b = acc[ai][bj][m][1];
                    float o[8] = {bflo(g.x) * a[0], bfhi(g.x) * a[1], bflo(g.y) * a[2], bfhi(g.y) * a[3], bflo(g.z) * b[0], bfhi(g.z) * b[1], bflo(g.w) * b[2], bfhi(g.w) * b[3]};
                    if (br > 0) { const u32x4 p = *(const u32x4*)(MG + off); o[0] += bflo(p.x); o[1] += bfhi(p.x); o[2] += bflo(p.y); o[3] += bfhi(p.y); o[4] += bflo(p.z); o[5] += bfhi(p.z); o[6] += bflo(p.w); o[7] += bfhi(p.w); }
                    u32x4 w; w.x = pk2(o[0], o[1]); w.y = pk2(o[2], o[3]); w.z = pk2(o[4], o[5]); w.w = pk2(o[6], o[7]); *(u32x4*)(MG + off) = w;
                }
    }
};

__constant__ float ROPE_INV[16] = {1.0f, 0.5623413324356079f, 0.3162277638912201f, 0.17782793939113617f, 0.10000000149011612f, 0.05623413249850273f, 0.03162277489900589f, 0.017782794311642647f,
                                   0.009999999776482582f, 0.005623413249850273f, 0.003162277629598975f, 0.0017782794311642647f, 0.0010000000474974513f, 0.000562341301701963f, 0.0003162277571391314f, 0.00017782794020604342f};
#define MFMA32(a, b, c) __builtin_amdgcn_mfma_f32_32x32x16_bf16((a), (b), (c), 0, 0, 0)
DI float xhalf_max(float m) { auto rr = __builtin_amdgcn_permlane32_swap(__float_as_uint(m), __float_as_uint(m), false, false); return __builtin_fmaxf(__uint_as_float(rr[0]), __uint_as_float(rr[1])); }
DI float xhalf_sum(float m) { auto rr = __builtin_amdgcn_permlane32_swap(__float_as_uint(m), __float_as_uint(m), false, false); return __uint_as_float(rr[0]) + __uint_as_float(rr[1]); }
template <int DQK, int DV, bool CAUSAL, int KT, bool PRIO>
DI void attn_unit(const bf16_t* Qb, int qpitch, const bf16_t* Kb, int kpitch, const bf16_t* Vtb, int vpitch, bf16_t* Ob, int opitch, int q0, int nt, LAS unsigned char* lds, float kbound, const float* qgain, const int* qpos, float qscale) {
    constexpr int KS = DQK * 2 + 16, VS = KT * 2 + 8, KBUF = KT * KS, VBUF = DV * VS, VOFF = 2 * KBUF;
    constexpr int KCH = DQK / 8, NKC = KT * KCH, NKR = (NKC + 511) / 512, VCH = KT / 8, NVC = DV * VCH, NVR = NVC / 512;
    constexpr float THR = 8.0f;
    static_assert(NVC % 512 == 0 && VOFF + 2 * VBUF <= 131072, "attention staging geometry");
    int tid_ = threadIdx.x; asm volatile("" : "+v"(tid_));
    const int tid = tid_, lane = tid & 63, r = lane & 31, h = lane >> 5, w = __builtin_amdgcn_readfirstlane(tid >> 6);
    u32x4 kreg[NKR], vreg[NVR];
    auto gload = [&](int kt) {
#pragma unroll
        for (int i = 0; i < NKR; ++i) { const int c = tid + i * 512; if (NKC % 512 == 0 || c < NKC) kreg[i] = *(const u32x4*)(Kb + (size_t)(kt * KT + c / KCH) * kpitch + (c % KCH) * 8); }
#pragma unroll
        for (int i = 0; i < NVR; ++i) { const int c = tid + i * 512; vreg[i] = *(const u32x4*)(Vtb + (size_t)(c / VCH) * vpitch + kt * KT + (c % VCH) * 8); }
    };
    auto lstore = [&](int buf) {
#pragma unroll
        for (int i = 0; i < NKR; ++i) { const int c = tid + i * 512; if (NKC % 512 == 0 || c < NKC) *(LAS u32x4*)(lds + buf * KBUF + (c / KCH) * KS + (c % KCH) * 16) = kreg[i]; }
#pragma unroll
        for (int i = 0; i < NVR; ++i) { const int c = tid + i * 512; LAS unsigned char* p = lds + VOFF + buf * VBUF + (c / VCH) * VS + (c % VCH) * 16;
            *(LAS u32x2*)p = (u32x2){vreg[i].x, vreg[i].y}; *(LAS u32x2*)(p + 8) = (u32x2){vreg[i].z, vreg[i].w}; }
    };
    gload(0);
    bf16x8 qf[DQK / 16];
#pragma unroll
    for (int ks = 0; ks < DQK / 16; ++ks) qf[ks] = *(const bf16x8*)(Qb + (size_t)(32 * w + r) * qpitch + 16 * ks + 8 * h);
    if (qgain) {
        float v[DQK / 16][8]; float q2 = 0.f;
#pragma unroll
        for (int ks = 0; ks < DQK / 16; ++ks)
#pragma unroll
            for (int e = 0; e < 8; ++e) { v[ks][e] = __uint_as_float(((unsigned)(unsigned short)qf[ks][e]) << 16); q2 += v[ks][e] * v[ks][e]; }
        q2 = xhalf_sum(q2);
        const float rq = __builtin_amdgcn_rsqf(q2 * (1.0f / (float)DQK) + EPS) * qscale;
#pragma unroll
        for (int ks = 0; ks < DQK / 16; ++ks) { const f32x4 g0 = *(const f32x4*)(qgain + 16 * ks + 8 * h), g1 = *(const f32x4*)(qgain + 16 * ks + 8 * h + 4);
#pragma unroll
            for (int e = 0; e < 4; ++e) { v[ks][e] *= rq * g0[e]; v[ks][4 + e] *= rq * g1[e]; } }
        if (DQK == 96 && qpos) {
        const float pos = (float)qpos[32 * w + r];
#pragma unroll
        for (int e = 0; e < 8; ++e) {
            const float ang = pos * ROPE_INV[8 * h + e]; const double rev = (double)ang * 0.15915494309189535; const float f = (float)(rev - floor(rev));
            const float c = __builtin_amdgcn_cosf(f), sn_ = __builtin_amdgcn_sinf(f), x1 = v[4][e], x2 = v[5][e];
            v[4][e] = x1 * c - x2 * sn_; v[5][e] = x2 * c + x1 * sn_; }
        }
#pragma unroll
        for (int ks = 0; ks < DQK / 16; ++ks) { u32x4 pw; pw.x = pk2(v[ks][0], v[ks][1]); pw.y = pk2(v[ks][2], v[ks][3]); pw.z = pk2(v[ks][4], v[ks][5]); pw.w = pk2(v[ks][6], v[ks][7]); qf[ks] = __builtin_bit_cast(bf16x8, pw); }
    }
    f32x16 o[DV / 32], negm;
#pragma unroll
    for (int i = 0; i < 16; ++i) negm[i] = 0.f;
#pragma unroll
    for (int d = 0; d < DV / 32; ++d)
#pragma unroll
        for (int i = 0; i < 16; ++i) o[d][i] = 0.f;
    float mrun = 0.f, lrun = 0.f; bool first = true;
    bool nomax = false;
    if (PRIO) {
        float q2 = 0.f;
#pragma unroll
        for (int ks = 0; ks < DQK / 16; ++ks)
#pragma unroll
            for (int e = 0; e < 8; ++e) { const float v = __uint_as_float(((unsigned)(unsigned short)qf[ks][e]) << 16); q2 += v * v; }
        q2 = xhalf_sum(q2);
        nomax = __all(sqrtf(q2) * kbound <= 100.0f) != 0;
    }
    lstore(0);
    __syncthreads();
    const int qabs = q0 + 32 * w + r, qlo = q0 + 32 * w;
    for (int kt = 0; kt < nt; ++kt) {
        const int buf = kt & 1;
        if (kt + 1 < nt) gload(kt + 1);
#pragma unroll
        for (int hf = 0; hf < KT / 64; ++hf) {
            const int key0 = kt * KT + 64 * hf;
            if (!CAUSAL || key0 <= qlo + 31) {
                if (PRIO) {
                    constexpr int KSN = DQK / 16, NDB = DV / 32;
                    f32x16 s0 = negm, s1 = negm;
                    const LAS unsigned char* kb = lds + buf * KBUF + (64 * hf + r) * KS + h * 16;
                    const LAS unsigned char* vb = lds + VOFF + buf * VBUF + r * VS + h * 8 + 128 * hf;
                    bf16x8 kf0[KSN], kf1[KSN], vf[4][NDB];
#pragma unroll
                    for (int ks = 0; ks < KSN; ++ks) { kf0[ks] = *(const LAS bf16x8*)(kb + ks * 32); kf1[ks] = *(const LAS bf16x8*)(kb + 32 * KS + ks * 32); }
                    __builtin_amdgcn_sched_barrier(0); __builtin_amdgcn_s_setprio(1); __builtin_amdgcn_sched_barrier(0);
#pragma unroll
                    for (int ks = 0; ks < KSN; ++ks) { s0 = MFMA32(kf0[ks], qf[ks], s0); s1 = MFMA32(kf1[ks], qf[ks], s1); }
                    __builtin_amdgcn_sched_barrier(0); __builtin_amdgcn_s_setprio(0); __builtin_amdgcn_sched_barrier(0);
#pragma unroll
                    for (int q4 = 0; q4 < 4; ++q4)
#pragma unroll
                        for (int d = 0; d < NDB; ++d) { const LAS unsigned char* vp = vb + d * 32 * VS + q4 * 32;
                            const s16x4 lo = *(const LAS s16x4*)vp, hi = *(const LAS s16x4*)(vp + 16); vf[q4][d] = (bf16x8){lo[0], lo[1], lo[2], lo[3], hi[0], hi[1], hi[2], hi[3]}; }
                    if (CAUSAL && key0 + 63 > qlo) {
#pragma unroll
                        for (int i = 0; i < 16; ++i) { const int key = key0 + (i & 3) + 8 * (i >> 2) + 4 * h; if (key > qabs) s0[i] = -1e30f; if (key + 32 > qabs) s1[i] = -1e30f; }
                    }
                    if (!nomax) {
                    float ra = __builtin_fmaxf(__builtin_fmaxf(s0[0], s0[1]), s1[0]), rb = __builtin_fmaxf(__builtin_fmaxf(s0[2], s0[3]), s1[1]);
                    ra = __builtin_fmaxf(__builtin_fmaxf(ra, s1[2]), s1[3]);
#pragma unroll
                    for (int i = 4; i < 16; i += 4) { ra = __builtin_fmaxf(__builtin_fmaxf(ra, s0[i]), s0[i + 1]); rb = __builtin_fmaxf(__builtin_fmaxf(rb, s0[i + 2]), s0[i + 3]);
                        ra = __builtin_fmaxf(__builtin_fmaxf(ra, s1[i]), s1[i + 1]); rb = __builtin_fmaxf(__builtin_fmaxf(rb, s1[i + 2]), s1[i + 3]); }
                    float rm = __builtin_fmaxf(ra, rb);
                    rm = xhalf_max(rm);
                    if (first || __any(rm > THR)) {
                        const float dl = first ? rm : fmaxf(rm, 0.f), f = __builtin_amdgcn_exp2f(-dl);
                        mrun += dl; lrun *= f; first = false;
#pragma unroll
                        for (int i = 0; i < 16; ++i) { s0[i] -= dl; s1[i] -= dl; negm[i] = -mrun; }
#pragma unroll
                        for (int d = 0; d < NDB; ++d)
#pragma unroll
                            for (int i = 0; i < 16; ++i) o[d][i] *= f;
                    }
                    }
                    float ps = 0.f;
#pragma unroll
                    for (int i = 0; i < 16; ++i) { s0[i] = __builtin_amdgcn_exp2f(s0[i]); ps += s0[i]; asm volatile("" : "+v"(ps)); }
#pragma unroll
                    for (int i = 0; i < 16; ++i) { s1[i] = __builtin_amdgcn_exp2f(s1[i]); ps += s1[i]; asm volatile("" : "+v"(ps)); }
                    lrun += ps;
                    bf16x8 pf[4];
#pragma unroll
                    for (int sf = 0; sf < 2; ++sf) {
                        u32x4 pw; pw.x = pk2(s0[8 * sf], s0[8 * sf + 1]); pw.y = pk2(s0[8 * sf + 2], s0[8 * sf + 3]); pw.z = pk2(s0[8 * sf + 4], s0[8 * sf + 5]); pw.w = pk2(s0[8 * sf + 6], s0[8 * sf + 7]); pf[sf] = __builtin_bit_cast(bf16x8, pw);
                        u32x4 pv; pv.x = pk2(s1[8 * sf], s1[8 * sf + 1]); pv.y = pk2(s1[8 * sf + 2], s1[8 * sf + 3]); pv.z = pk2(s1[8 * sf + 4], s1[8 * sf + 5]); pv.w = pk2(s1[8 * sf + 6], s1[8 * sf + 7]); pf[2 + sf] = __builtin_bit_cast(bf16x8, pv);
                    }
                    __builtin_amdgcn_sched_barrier(0); __builtin_amdgcn_s_setprio(1); __builtin_amdgcn_sched_barrier(0);
#pragma unroll
                    for (int q4 = 0; q4 < 4; ++q4)
#pragma unroll
                        for (int d = 0; d < NDB; ++d) o[d] = MFMA32(vf[q4][d], pf[q4], o[d]);
                    __builtin_amdgcn_sched_barrier(0); __builtin_amdgcn_s_setprio(0); __builtin_amdgcn_sched_barrier(0);
                } else {
                    f32x16 s0, s1;
                    if (PRIO) { s0 = negm; s1 = negm; } else {
#pragma unroll
                        for (int i = 0; i < 16; ++i) { s0[i] = 0.f; s1[i] = 0.f; } }
                    const LAS unsigned char* kb = lds + buf * KBUF + (64 * hf + r) * KS + h * 16;
                    if (PRIO) __builtin_amdgcn_s_setprio(1);
#pragma unroll
                    for (int ks = 0; ks < DQK / 16; ++ks) {
                        const bf16x8 a0 = *(const LAS bf16x8*)(kb + ks * 32), a1 = *(const LAS bf16x8*)(kb + 32 * KS + ks * 32);
                        s0 = MFMA32(a0, qf[ks], s0); s1 = MFMA32(a1, qf[ks], s1);
                    }
                    if (PRIO) __builtin_amdgcn_s_setprio(0);
                    if (CAUSAL && key0 + 63 > qlo) {
#pragma unroll
                        for (int i = 0; i < 16; ++i) { const int key = key0 + (i & 3) + 8 * (i >> 2) + 4 * h; if (key > qabs) s0[i] = -1e30f; if (key + 32 > qabs) s1[i] = -1e30f; }
                    }
                    if (!PRIO) {
#pragma unroll
                        for (int i = 0; i < 16; ++i) { s0[i] -= mrun; s1[i] -= mrun; } }
                    float rm = fmaxf(s0[0], s1[0]);
#pragma unroll
                    for (int i = 1; i < 16; ++i) rm = fmaxf(rm, fmaxf(s0[i], s1[i]));
                    rm = xhalf_max(rm);
                    if (first || __any(rm > THR)) {
                        const float dl = first ? rm : fmaxf(rm, 0.f), f = __builtin_amdgcn_exp2f(-dl);
                        mrun += dl; lrun *= f; first = false;
#pragma unroll
                        for (int i = 0; i < 16; ++i) { s0[i] -= dl; s1[i] -= dl; if (PRIO) negm[i] = -mrun; }
#pragma unroll
                        for (int d = 0; d < DV / 32; ++d)
#pragma unroll
                            for (int i = 0; i < 16; ++i) o[d][i] *= f;
                    }
                    const LAS unsigned char* vb = lds + VOFF + buf * VBUF + r * VS + h * 8 + 128 * hf;
                    float ps = 0.f;
#pragma unroll
                    for (int kb2 = 0; kb2 < 2; ++kb2) {
                        f32x16& sx = kb2 == 0 ? s0 : s1;
#pragma unroll
                        for (int i = 0; i < 16; ++i) { sx[i] = __builtin_amdgcn_exp2f(sx[i]); ps += sx[i]; }
                        if (PRIO) __builtin_amdgcn_s_setprio(1);
#pragma unroll
                        for (int sf = 0; sf < 2; ++sf) {
                            u32x4 pw; pw.x = pk2(sx[8 * sf], sx[8 * sf + 1]); pw.y = pk2(sx[8 * sf + 2], sx[8 * sf + 3]); pw.z = pk2(sx[8 * sf + 4], sx[8 * sf + 5]); pw.w = pk2(sx[8 * sf + 6], sx[8 * sf + 7]);
                            const bf16x8 pf = __builtin_bit_cast(bf16x8, pw);
#pragma unroll
                            for (int d = 0; d < DV / 32; ++d) {
                                const LAS unsigned char* vp = vb + d * 32 * VS + (32 * kb2 + 16 * sf) * 2;
                                const s16x4 lo = *(const LAS s16x4*)vp, hi = *(const LAS s16x4*)(vp + 16);
                                const bf16x8 a = (bf16x8){lo[0], lo[1], lo[2], lo[3], hi[0], hi[1], hi[2], hi[3]};
                                o[d] = MFMA32(a, pf, o[d]);
                                if (!PRIO) asm volatile("" ::: "memory");
                            }
                        }
                        if (PRIO) __builtin_amdgcn_s_setprio(0);
                    }
                    lrun += ps;
                }
            }
        }
        if (kt + 1 < nt) lstore(buf ^ 1);
        __syncthreads();
    }
    lrun = xhalf_sum(lrun);
    const float inv = 1.0f / lrun;
    bf16_t* orow = Ob + (size_t)(32 * w + r) * opitch;
#pragma unroll
    for (int d = 0; d < DV / 32; ++d)
#pragma unroll
        for (int g = 0; g < 4; ++g) { u32x2 wv; wv.x = pk2(o[d][4 * g] * inv, o[d][4 * g + 1] * inv); wv.y = pk2(o[d][4 * g + 2] * inv, o[d][4 * g + 3] * inv);
            *(u32x2*)(orow + 32 * d + 8 * g + 4 * h) = wv; }
}

#define MFMA16(a, b, c) __builtin_amdgcn_mfma_f32_16x16x32_bf16((a), (b), (c), 0, 0, 0)
DI void sgu_item(int g, int bc, int par, const bf16_t* SGW, const bf16_t* Vg, const float* VST, const float* lng, const float* lnb, const float* sgb, bf16_t* U, LAS unsigned char* lds) {
    constexpr int RS = 272;
    const int tid = threadIdx.x, lane = tid & 63, w = __builtin_amdgcn_readfirstlane(tid >> 6), row0 = bc * 128;
    LAS unsigned char* Wl = lds + par * (192 * RS); LAS unsigned char* Vl = Wl + 128 * RS;
    const int j = lane & 15, q = lane >> 4, t0 = 16 * w, nks = (t0 + 15) / 32 + 1, t = t0 + j;
    u32x4 wreg[4];
#pragma unroll
    for (int i = 0; i < 4; ++i) { const int c = tid + i * 512, rr = c >> 4, cc = c & 15; wreg[i] = *(const u32x4*)(SGW + (size_t)g * 16384 + rr * 128 + cc * 8); }
    const int s = tid & 127, dg = tid >> 7, row = row0 + s;
    f32x4 pst[8];
#pragma unroll
    for (int i = 0; i < 8; ++i) pst[i] = *(const f32x4*)(VST + (size_t)row * 32 + 4 * i);
    const u32x4 a = *(const u32x4*)(Vg + (size_t)row * 512 + g * 64 + dg * 16), b = *(const u32x4*)(Vg + (size_t)row * 512 + g * 64 + dg * 16 + 8);
    bf16_t* up = U + (size_t)(row0 + t) * 512 + g * 64 + 4 * q;
    u32x2 uu[4];
#pragma unroll
    for (int db = 0; db < 4; ++db) uu[db] = *(const u32x2*)(up + 16 * db);
    const float bias = sgb[g * 128 + t];
#pragma unroll
    for (int i = 0; i < 4; ++i) { const int c = tid + i * 512, rr = c >> 4, cc = c & 15; *(LAS u32x4*)(Wl + rr * RS + cc * 16) = wreg[i]; }
    {
        float s1 = 0.f, s2 = 0.f;
#pragma unroll
        for (int i = 0; i < 8; ++i) { s1 += pst[i][0] + pst[i][2]; s2 += pst[i][1] + pst[i][3]; }
        const float mu = s1 * (1.0f / 512.0f), var = s2 * (1.0f / 512.0f) - mu * mu, rstd = __builtin_amdgcn_rsqf(fmaxf(var, 0.f) + EPS);
        const unsigned wd[8] = {a.x, a.y, a.z, a.w, b.x, b.y, b.z, b.w};
#pragma unroll
        for (int i = 0; i < 8; ++i) {
            const int d = dg * 16 + 2 * i, c = g * 64 + d;
            const float v0 = (bflo(wd[i]) - mu) * rstd * lng[c] + lnb[c], v1 = (bfhi(wd[i]) - mu) * rstd * lng[c + 1] + lnb[c + 1];
            *(LAS bf16_t*)(Vl + d * RS + s * 2) = (bf16_t)f2bf(v0); *(LAS bf16_t*)(Vl + (d + 1) * RS + s * 2) = (bf16_t)f2bf(v1);
        }
    }
    __syncthreads();
    f32x4 acc[4];
#pragma unroll
    for (int db = 0; db < 4; ++db) acc[db] = (f32x4){0.f, 0.f, 0.f, 0.f};
    for (int ks = 0; ks < nks; ++ks) {
        const bf16x8 bw = *(const LAS bf16x8*)(Wl + (t0 + j) * RS + (32 * ks + 8 * q) * 2);
#pragma unroll
        for (int db = 0; db < 4; ++db) { const bf16x8 av = *(const LAS bf16x8*)(Vl + (16 * db + j) * RS + (32 * ks + 8 * q) * 2); acc[db] = MFMA16(av, bw, acc[db]); }
    }
#pragma unroll
    for (int db = 0; db < 4; ++db) {
        u32x2 wv; wv.x = pk2(bflo(uu[db].x) * (acc[db][0] + bias), bfhi(uu[db].x) * (acc[db][1] + bias)); wv.y = pk2(bflo(uu[db].y) * (acc[db][2] + bias), bfhi(uu[db].y) * (acc[db][3] + bias));
        *(u32x2*)(up + 16 * db) = wv;
    }
}

DI float wave_sum(float v) {
#pragma unroll
    for (int o = 1; o < 64; o <<= 1) v += __shfl_xor(v, o);
    return v;
}
DI bf16_t* dest_rows(int mode, int n0, int K, bf16_t* d0, bf16_t* d1) {
    if (mode == 1) { const int isu = n0 >= FF ? 1 : 0, c = n0 - isu * FF; return d0 + (size_t)((c >> 7) * 256 + isu * 128 + (c & 127)) * K; }
    if (mode == 2) {
        if (n0 < 1664) return d0 + (size_t)n0 * K;
        if (n0 < 1696) return d0 + (size_t)(2176 + n0 - 1664) * K;
        if (n0 < 2208) return d0 + (size_t)(1664 + n0 - 1696) * K;
        return d1 + (size_t)(n0 - 2208) * K;
    }
    return d0 + (size_t)n0 * K;
}
DI void transpose_mat(const float* W, int K, int N, const float* gk, int mode, bf16_t* d0, bf16_t* d1, LAS float* scr, int gw, int ngw, int lane, int nb0 = 0, int nb1 = -1) {
    if (nb1 < 0) nb1 = N / 32;
    const int nblk = nb1 - nb0, nitems = (K / 64) * nblk;
    for (int item = gw; item < nitems; item += ngw) {
        const int kb = item / nblk, nb = nb0 + item % nblk, k0 = 64 * kb, n0 = 32 * nb;
        float tv[32];
#pragma unroll
        for (int i = 0; i < 32; ++i) { const int kk = 2 * i + (lane >> 5); tv[i] = W[(size_t)(k0 + kk) * N + n0 + (lane & 31)]; }
#pragma unroll
        for (int i = 0; i < 32; ++i) { const int kk = 2 * i + (lane >> 5); float v = tv[i]; if (gk) v *= gk[k0 + kk]; scr[kk * 33 + (lane & 31)] = v; }
        asm volatile("s_waitcnt lgkmcnt(0)" ::: "memory");
        bf16_t* dst = dest_rows(mode, n0, K, d0, d1);
        const int c = lane & 7;
#pragma unroll
        for (int jj = 0; jj < 4; ++jj) { const int n = (lane >> 3) + 8 * jj; const LAS float* s = scr + (8 * c) * 33 + n;
            u32x4 o; o.x = pk2(s[0 * 33], s[1 * 33]); o.y = pk2(s[2 * 33], s[3 * 33]); o.z = pk2(s[4 * 33], s[5 * 33]); o.w = pk2(s[6 * 33], s[7 * 33]);
            *(u32x4*)(dst + (size_t)n * K + k0 + 8 * c) = o; }
        asm volatile("s_waitcnt lgkmcnt(0)" ::: "memory");
    }
}
DI void rms_row_to_bf16(const float* xrow, const float* gain, bf16_t* orow, int lane) {
    const f32x4* xr = (const f32x4*)xrow + lane;
    f32x4 v[4]; float s = 0.f;
#pragma unroll
    for (int jj = 0; jj < 4; ++jj) { v[jj] = xr[64 * jj]; s += (v[jj][0] * v[jj][0] + v[jj][1] * v[jj][1]) + (v[jj][2] * v[jj][2] + v[jj][3] * v[jj][3]); }
    const float rstd = 1.0f / sqrtf(wave_sum(s) * (1.0f / 1024.0f) + EPS);
    u32x2* o8 = (u32x2*)orow + lane;
#pragma unroll
    for (int jj = 0; jj < 4; ++jj) {
        f32x4 gg = (f32x4){1.f, 1.f, 1.f, 1.f}; if (gain) gg = ((const f32x4*)gain)[lane + 64 * jj];
        u32x2 wv; wv.x = pk2(v[jj][0] * rstd * gg[0], v[jj][1] * rstd * gg[1]); wv.y = pk2(v[jj][2] * rstd * gg[2], v[jj][3] * rstd * gg[3]); o8[64 * jj] = wv;
    }
}

#define RLX_AGENT __ATOMIC_RELAXED, __HIP_MEMORY_SCOPE_AGENT
#define XB_TMO      128
#define XB_XCNT(j)  (256  + 64 * (j))
#define XB_XSUB(j)  (1280 + 64 * (j))
#define XB_XGEN(j)  (2304 + 64 * (j))
#define XB_TOP      3328
#define XB_TOPGEN   3392
#define XCD_BAR_WORDS 3456
#define XB_SPIN_CAP (1u << 18)

__device__ __forceinline__ unsigned xb_ld(unsigned* p)              { return __hip_atomic_load(p, __ATOMIC_RELAXED, __HIP_MEMORY_SCOPE_AGENT); }
__device__ __forceinline__ unsigned xb_add(unsigned* p, unsigned v) { return __hip_atomic_fetch_add(p, v, __ATOMIC_RELAXED, __HIP_MEMORY_SCOPE_AGENT); }
__device__ __forceinline__ unsigned xb_xcc_id() { return (unsigned)__builtin_amdgcn_s_getreg((3 << 11) | 20) & 0xFu; }
#define XB_SPIN(cond, bar) do { unsigned _sp = 0; while (cond) { __builtin_amdgcn_s_sleep(1); \
    if ((++_sp & 255u) == 0u) { if (xb_ld(&(bar)[XB_TMO])) break; if (_sp > XB_SPIN_CAP) { atomicAdd(&(bar)[XB_TMO], 1u); break; } } } } while (0)

struct XcdBarrier {
    unsigned* bar; unsigned x;
    volatile LAS unsigned* st;
};

__device__ __forceinline__ XcdBarrier xcd_barrier_post(unsigned* bar, volatile LAS unsigned* st) {
    XcdBarrier b; b.bar = bar; b.x = xb_xcc_id(); b.st = st;
    if (threadIdx.x == 0) (void)xb_add(&bar[XB_XCNT(b.x)], 1u);
    return b;
}
__device__ __forceinline__ void xcd_barrier_complete(unsigned* bar, unsigned x, unsigned& nloc, unsigned& nx) {
    const unsigned G = gridDim.x * gridDim.y * gridDim.z;
    unsigned sum, cnt, mine, sp = 0u;
    for (;;) {
        sum = 0u; cnt = 0u; mine = 0u;
#pragma unroll
        for (unsigned j = 0; j < 16; ++j) { const unsigned c = xb_ld(&bar[XB_XCNT(j)]); sum += c; cnt += (c > 0u) ? 1u : 0u; mine = (j == x) ? c : mine; }
        if (sum == G) break;
        __builtin_amdgcn_s_sleep(1);
        if ((++sp & 255u) == 0u) { if (xb_ld(&bar[XB_TMO])) break; if (sp > XB_SPIN_CAP) { atomicAdd(&bar[XB_TMO], 1u); break; } }
    }
    nloc = mine > 0u ? mine : 1u; nx = cnt > 0u ? cnt : 1u;
}

__device__ __forceinline__ void xcd_barrier(const XcdBarrier& b) {
    asm volatile("s_waitcnt vmcnt(0)" ::: "memory");
    __syncthreads();
    if (threadIdx.x == 0) {
        unsigned* bar = b.bar;
        __builtin_amdgcn_s_waitcnt(0);
        unsigned nloc = b.st[0], nx = b.st[1];
        if (nloc == 0u) { xcd_barrier_complete(bar, b.x, nloc, nx); b.st[0] = nloc; b.st[1] = nx; }
        const unsigned old = xb_add(&bar[XB_XSUB(b.x)], 1u);
        const unsigned gen = old / nloc;
        if (old + 1u == (gen + 1u) * nloc) {
            __builtin_amdgcn_fence(__ATOMIC_RELEASE, "agent");
            asm volatile("s_waitcnt vmcnt(0)" ::: "memory");
            const unsigned og = xb_add(&bar[XB_TOP], 1u);
            const unsigned tg = og / nx;
            if (og + 1u == (tg + 1u) * nx) xb_add(&bar[XB_TOPGEN], 1u);
            else XB_SPIN(xb_ld(&bar[XB_TOPGEN]) == tg, bar);
            __builtin_amdgcn_fence(__ATOMIC_ACQUIRE, "agent");
            xb_add(&bar[XB_XGEN(b.x)], 1u);
            asm volatile("s_waitcnt vmcnt(0)" ::: "memory");
        } else {
            XB_SPIN(xb_ld(&bar[XB_XGEN(b.x)]) == gen, bar);
            __builtin_amdgcn_fence(__ATOMIC_ACQUIRE, "agent");
            asm volatile("s_waitcnt vmcnt(0)" ::: "memory");
        }
    }
    __syncthreads();
}

struct Args { const float* in[30]; float* out; unsigned char* ws; int ph_lo, ph_hi; };
constexpr int LDS_BYTES = 135168;
constexpr int NPH = 12;


#define wGU1 ((bf16_t*)(ws + W_GU1))
#define wDN1 ((bf16_t*)(ws + W_DN1))
#define wIN ((bf16_t*)(ws + W_IN))
#define wGT ((bf16_t*)(ws + W_GT))
#define wUQ ((bf16_t*)(ws + W_UQ))
#define wUKV ((bf16_t*)(ws + W_UKV))
#define wMKV ((bf16_t*)(ws + W_MKV))
#define wBA ((bf16_t*)(ws + W_BA))
#define wBB ((bf16_t*)(ws + W_BB))
#define wBC ((bf16_t*)(ws + W_BC))
#define wOUT ((bf16_t*)(ws + W_OUT))
#define wGU2 ((bf16_t*)(ws + W_GU2))
#define wDN2 ((bf16_t*)(ws + W_DN2))
#define wSG ((bf16_t*)(ws + W_SG))
#define SS1 ((float*)(ws + S_SS1))
#define SS2 ((float*)(ws + S_SS2))
#define VST ((float*)(ws + S_VST))
#define CQP ((float*)(ws + S_CQP))
#define CKVP ((float*)(ws + S_CKVP))
#define QMP ((float*)(ws + S_QMP))
#define KR ((float*)(ws + S_KR))
#define MEMN ((bf16_t*)(ws + S_MEMN))
#define MKV ((float*)(ws + S_MKV))
#define KM ((bf16_t*)(ws + S_KM))
#define VMT ((bf16_t*)(ws + S_VMT))
#define X1B ((bf16_t*)(ws + B_X1B))
#define MG ((bf16_t*)(ws + B_MG))
#define U ((bf16_t*)(ws + B_U))
#define QM ((bf16_t*)(ws + B_QM))
#define VG ((bf16_t*)(ws + B_VG))
#define KF ((bf16_t*)(ws + B_K))
#define CQ ((bf16_t*)(ws + B_CQ))
#define CKV ((bf16_t*)(ws + B_CKV))
#define QRAW ((bf16_t*)(ws + B_QRAW))
#define KN ((bf16_t*)(ws + B_KN))
#define VT ((bf16_t*)(ws + B_VT))
#define YB ((bf16_t*)(ws + B_YB))
#define YC ((bf16_t*)(ws + B_YC))
#define G0 ((bf16_t*)(ws + B_G0))
#define G1 ((bf16_t*)(ws + B_G1))
#define G2 ((bf16_t*)(ws + B_G2))
#define ACT ((bf16_t*)(ws + B_ACT))
#define XB ((bf16_t*)(ws + B_XB))
#define X2B ((bf16_t*)(ws + B_X2B))
#define MGO ((bf16_t*)out)
DI unsigned char* opaque_ptr(unsigned char* p) { asm volatile("" : "+s"(p)); return p; }
__global__ void __launch_bounds__(512, 2) fwd_mega(Args args) {
    extern __shared__ __attribute__((aligned(16))) unsigned char lds_raw[];
    LAS unsigned char* lds = (LAS unsigned char*)lds_raw;
    cg::grid_group grid = cg::this_grid();
    const int tid = threadIdx.x, lane = tid & 63, wave = __builtin_amdgcn_readfirstlane(tid >> 6);
    const int G = gridDim.x, bx = blockIdx.x;
    const float* x = args.in[0]; const float* mem = args.in[1]; const int* positions = (const int*)args.in[2];
    float* out = args.out;
    const int lo = args.ph_lo, hi = args.ph_hi;
#ifndef PH_MASK
#define PH_MASK 0xFFF
#endif
#define IN(k) (((PH_MASK >> (k)) & 1) && lo <= (k) && (k) < hi)
#ifndef DUP_MASK
#define DUP_MASK 0
#endif
#define DUP(k) for (int rep_ = 0; rep_ < 1 + ((DUP_MASK >> (k)) & 1); ++rep_)
#define SEAM(k) do { if (IN(k) && IN((k) + 1)) xcd_barrier(xbar); } while (0)
    if (args.ph_lo < 0) grid.sync();
    if (tid < 4) ((LAS unsigned*)(lds + 131072 + 1024))[tid] = 0u;
    __syncthreads();
    XcdBarrier xbar = xcd_barrier_post((unsigned*)(args.ws + S_BAR), (volatile LAS unsigned*)(lds + 131072 + 1024));
    const int gw = bx * 8 + wave, ngw = G * 8, gt = bx * 512 + tid, ngt = G * 512;

    if (IN(0)) DUP(0) { unsigned char* ws = opaque_ptr(args.ws);
        LAS float* scr = (LAS float*)(lds + wave * 16384);
        const bool defer = (G == 256);
        transpose_mat(args.in[4], 1024, 5632, args.in[3], 1, wGU1, nullptr, scr, gw, ngw, lane);
        transpose_mat(args.in[20], 1024, 1024, nullptr, 0, wMKV, nullptr, scr, gw, ngw, lane);
        if (!defer) {
            transpose_mat(args.in[5], 2816, 1024, nullptr, 0, wDN1, nullptr, scr, gw, ngw, lane);
            transpose_mat(args.in[7], 1024, 5280, args.in[6], 2, wIN, wGT, scr, gw, ngw, lane);
            transpose_mat(args.in[14], 384, 768, args.in[13], 0, wUQ, nullptr, scr, gw, ngw, lane);
            transpose_mat(args.in[16], 256, 1024, args.in[15], 0, wUKV, nullptr, scr, gw, ngw, lane);
            transpose_mat(args.in[23], 512, 1024, nullptr, 0, wBA, nullptr, scr, gw, ngw, lane);
            transpose_mat(args.in[24], 512, 1024, nullptr, 0, wBB, nullptr, scr, gw, ngw, lane);
            transpose_mat(args.in[25], 512, 1024, nullptr, 0, wBC, nullptr, scr, gw, ngw, lane);
            transpose_mat(args.in[26], 1024, 1024, nullptr, 0, wOUT, nullptr, scr, gw, ngw, lane);
            transpose_mat(args.in[28], 1024, 5632, args.in[27], 1, wGU2, nullptr, scr, gw, ngw, lane);
            transpose_mat(args.in[29], 2816, 1024, nullptr, 0, wDN2, nullptr, scr, gw, ngw, lane);
        }
        for (int i = gt; i < 96 * 1024 / 8; i += ngt) ((u32x4*)(wIN + (size_t)2208 * 1024))[i] = (u32x4){0u, 0u, 0u, 0u};
        for (int i = gt; i < T; i += ngt) { SS1[i] = 0.f; SS2[i] = 0.f; CQP[i] = 0.f; CKVP[i] = 0.f; }
        for (int m = 2 * gw; m < T; m += 2 * ngw) {
            const f32x4* x0 = (const f32x4*)(x + (size_t)m * DM) + lane; const f32x4* x1 = x0 + DM / 4;
            f32x4 v0[4], v1[4]; float s0 = 0.f, s1 = 0.f;
#pragma unroll
            for (int jj = 0; jj < 4; ++jj) { v0[jj] = x0[64 * jj]; v1[jj] = x1[64 * jj]; }
#pragma unroll
            for (int jj = 0; jj < 4; ++jj) { s0 += (v0[jj][0] * v0[jj][0] + v0[jj][1] * v0[jj][1]) + (v0[jj][2] * v0[jj][2] + v0[jj][3] * v0[jj][3]);
                                             s1 += (v1[jj][0] * v1[jj][0] + v1[jj][1] * v1[jj][1]) + (v1[jj][2] * v1[jj][2] + v1[jj][3] * v1[jj][3]); }
            const float q0_ = sqrtf(wave_sum(s0) * (1.0f / 1024.0f) + EPS), q1_ = sqrtf(wave_sum(s1) * (1.0f / 1024.0f) + EPS), r0 = 1.0f / q0_, r1 = 1.0f / q1_;
            if (lane == 0) { ((float*)(ws + S_R0))[m] = q0_; ((float*)(ws + S_R0))[m + 1] = q1_; }
            u32x2* o0 = (u32x2*)(XB + (size_t)m * DM) + lane; u32x2* o1 = o0 + DM / 4;
#pragma unroll
            for (int jj = 0; jj < 4; ++jj) { u32x2 w0, w1; w0.x = pk2(v0[jj][0] * r0, v0[jj][1] * r0); w0.y = pk2(v0[jj][2] * r0, v0[jj][3] * r0); w1.x = pk2(v1[jj][0] * r1, v1[jj][1] * r1); w1.y = pk2(v1[jj][2] * r1, v1[jj][3] * r1);
                o0[64 * jj] = w0; o1[64 * jj] = w1; }
        }
        for (int m = gw; m < 512; m += ngw) rms_row_to_bf16(mem + (size_t)m * DM, args.in[19], MEMN + (size_t)m * DM, lane);
        { const float* sgw = args.in[11];
          for (int i = gt; i < 8 * 128 * 128 / 2; i += ngt) { const int e = 2 * i, s = e & 127, t = (e >> 7) & 127; const float a = s <= t ? sgw[e] : 0.f, b = (s + 1) <= t ? sgw[e + 1] : 0.f; ((unsigned*)wSG)[i] = pk2(a, b); } }
    }
    SEAM(0);
#ifdef EXTRA_SYNCS
    for (int i_ = 0; i_ < EXTRA_SYNCS; ++i_) xcd_barrier(xbar);
#endif
    if (IN(1)) DUP(1) { unsigned char* ws = opaque_ptr(args.ws);
        { pg8::Gemm g{XB, wGU1, T, 5632, 1024}; pg8::StaticOrder S; S.init(T, 5632, G, bx); EpiSwiglu<0> E{ACT, nullptr};
          pg8::gemm_phase<EpiSwiglu<0>, pg8::StaticOrder, true, true>(lds, g, S, E); }
        { pg8::Gemm g{MEMN, wMKV, 512, 1024, 1024}; pg8::StaticOrder S; S.init(512, 1024, G, (bx + 128) % G); EpiF32 E{MKV, 1024};
          pg8::gemm_phase<EpiF32, pg8::StaticOrder, true, true>(lds, g, S, E); }
        if (G == 256 && bx >= 128) {
            LAS float* scr = (LAS float*)(lds + wave * 16384); const int gw2 = (bx - 128) * 8 + wave, ngw2 = 128 * 8;
            transpose_mat(args.in[5], 2816, 1024, nullptr, 0, wDN1, nullptr, scr, gw2, ngw2, lane);
            transpose_mat(args.in[7], 1024, 5280, args.in[6], 2, wIN, wGT, scr, gw2, ngw2, lane, 0, 69);
            transpose_mat(args.in[14], 384, 768, args.in[13], 0, wUQ, nullptr, scr, gw2, ngw2, lane);
            transpose_mat(args.in[16], 256, 1024, args.in[15], 0, wUKV, nullptr, scr, gw2, ngw2, lane);
        }
    }
    SEAM(1);
    if (IN(2)) DUP(2) { unsigned char* ws = opaque_ptr(args.ws); const bool dry = rep_ < ((DUP_MASK >> 2) & 1);
        pg8::Gemm g{ACT, wDN1, T, 1024, FF}; pg8::StaticOrder S; S.init(T, 1024, G, bx); EpiResid<true, true, false> E{(const float*)(ws + S_R0), XB, nullptr, X1B, dry ? (float*)(ws + S_DUMMY) : SS1, 0.5f};
        pg8::gemm_phase<EpiResid<true, true, false>, pg8::StaticOrder, true, true>(lds, g, S, E);
    }
    SEAM(2);
    if (IN(3)) DUP(3) { unsigned char* ws = opaque_ptr(args.ws); const bool dry = rep_ < ((DUP_MASK >> 3) & 1);
        pg8::Gemm g{X1B, wIN, T, NWIN, 1024}; pg8::StaticOrder S; S.init(T, NWIN, G, bx); EpiWin E{SS1, U, VG, CQ, CKV, QM, KR, VST, dry ? (float*)(ws + S_DUMMY) : CQP, dry ? (float*)(ws + S_DUMMY) : CKVP, QMP};
        pg8::gemm_phase<EpiWin, pg8::StaticOrder, true, true>(lds, g, S, E);
        if (G == 256 && bx >= 64) {
            LAS float* scr = (LAS float*)(lds + wave * 16384); const int gw2 = (bx - 64) * 8 + wave, ngw2 = 192 * 8;
            transpose_mat(args.in[7], 1024, 5280, args.in[6], 2, wIN, wGT, scr, gw2, ngw2, lane, 69, 165);
            transpose_mat(args.in[23], 512, 1024, nullptr, 0, wBA, nullptr, scr, gw2, ngw2, lane);
            transpose_mat(args.in[24], 512, 1024, nullptr, 0, wBB, nullptr, scr, gw2, ngw2, lane);
            transpose_mat(args.in[25], 512, 1024, nullptr, 0, wBC, nullptr, scr, gw2, ngw2, lane);
            transpose_mat(args.in[26], 1024, 1024, nullptr, 0, wOUT, nullptr, scr, gw2, ngw2, lane);
            transpose_mat(args.in[28], 1024, 5632, args.in[27], 1, wGU2, nullptr, scr, gw2, ngw2, lane);
            transpose_mat(args.in[29], 2816, 1024, nullptr, 0, wDN2, nullptr, scr, gw2, ngw2, lane);
        }
    }
    SEAM(3);
    if (IN(4)) DUP(4) { unsigned char* ws = opaque_ptr(args.ws); const bool dry = rep_ < ((DUP_MASK >> 4) & 1);
#ifndef NO_UQ
        { int kk = 384; asm volatile("" : "+s"(kk)); pg8::Gemm g{CQ, wUQ, T, 768, kk}; pg8::StaticOrder S; S.init(T, 768, G, bx); EpiUq E{CQP, QRAW};
          pg8::gemm_phase<EpiUq, pg8::StaticOrder, true, true>(lds, g, S, E); }
#endif
#ifndef NO_UKV
        { int kk = 256; asm volatile("" : "+s"(kk)); pg8::Gemm g{CKV, wUKV, T, 1024, kk}; pg8::StaticOrder S; S.init(T, 1024, G, bx); EpiUkv E{CKVP, KN, VT};
          pg8::gemm_phase<EpiUkv, pg8::StaticOrder, true, true>(lds, g, S, E); }
#endif
        __syncthreads();
#ifndef NO_SGU
        if (!dry) { int par = 0; for (int it = bx; it < 1024; it += G, par ^= 1) sgu_item(it >> 7, it & 127, par, wSG, VG, VST, args.in[9], args.in[10], args.in[12], U, lds); __syncthreads(); }
#endif
    }
    SEAM(4);
    if (IN(5)) { unsigned char* ws = opaque_ptr(args.ws);
        {
            constexpr int NB = 4;
            const float* qn = args.in[17]; const float* kn = args.in[18];
            const int m = lane & 15, grp = lane >> 4; const bool act = m < 12, isrope = m >= 8 && m < 12, isx1 = m < 10; const int mm = act ? m : 0, i0 = 8 * (m & 1);
            float gq[8], gk[8], inv[8];
#pragma unroll
            for (int e = 0; e < 8; ++e) { gq[e] = qn[8 * mm + e] * QSCALE_MLA; gk[e] = kn[8 * mm + e]; inv[e] = ROPE_INV[i0 + e]; }
#pragma unroll 1
            for (int it0 = gw * NB; it0 < T * 2; it0 += ngw * NB) {
                u32x4 qa[NB], ka[NB]; f32x4 kb0[NB], kb1[NB]; float pos[NB];
#pragma unroll
                for (int u = 0; u < NB; ++u) {
                    const int task = (it0 + u) * 4 + grp, tok = task >> 3, hd = task & 7;
                    pos[u] = (float)positions[tok];
                    qa[u] = (u32x4){0u, 0u, 0u, 0u}; ka[u] = (u32x4){0u, 0u, 0u, 0u}; kb0[u] = (f32x4){0.f, 0.f, 0.f, 0.f}; kb1[u] = (f32x4){0.f, 0.f, 0.f, 0.f};
                    if (m < 8) ka[u] = *(const u32x4*)(KN + (size_t)tok * 512 + hd * 64 + 8 * m);
                    if (isrope) { kb0[u] = *(const f32x4*)(KR + (size_t)tok * 32 + 8 * (m - 8)); kb1[u] = *(const f32x4*)(KR + (size_t)tok * 32 + 8 * (m - 8) + 4); }
                }
#pragma unroll
                for (int u = 0; u < NB; ++u) {
                    const int task = (it0 + u) * 4 + grp, tok = task >> 3, hd = task & 7;
                    float cs[8], sn[8];
#pragma unroll
                    for (int e = 0; e < 8; ++e) { const float ang = pos[u] * inv[e]; const double rev = (double)ang * 0.15915494309189535; const float f = (float)(rev - floor(rev));
                        cs[e] = __builtin_amdgcn_cosf(f); sn[e] = __builtin_amdgcn_sinf(f); }
                    float v[8];
                    {
                        const u32x4 a = ka[u];
                        if (m < 8) { v[0] = bflo(a.x); v[1] = bfhi(a.x); v[2] = bflo(a.y); v[3] = bfhi(a.y); v[4] = bflo(a.z); v[5] = bfhi(a.z); v[6] = bflo(a.w); v[7] = bfhi(a.w); }
                        else { v[0] = kb0[u][0]; v[1] = kb0[u][1]; v[2] = kb0[u][2]; v[3] = kb0[u][3]; v[4] = kb1[u][0]; v[5] = kb1[u][1]; v[6] = kb1[u][2]; v[7] = kb1[u][3]; }
                        float ss = 0.f;
#pragma unroll
                        for (int e = 0; e < 8; ++e) ss += v[e] * v[e];
                        ss += __shfl_xor(ss, 1); ss += __shfl_xor(ss, 2); ss += __shfl_xor(ss, 4); ss += __shfl_xor(ss, 8);
                        const float rk = __builtin_amdgcn_rsqf(ss * (1.0f / 96.0f) + EPS);
#pragma unroll
                        for (int e = 0; e < 8; ++e) v[e] = v[e] * rk * gk[e];
#pragma unroll
                        for (int e = 0; e < 8; ++e) { const float o = __shfl_xor(v[e], 2); if (isrope) v[e] = isx1 ? v[e] * cs[e] - o * sn[e] : v[e] * cs[e] + o * sn[e]; }
                        if (act) { u32x4 w; w.x = pk2(v[0], v[1]); w.y = pk2(v[2], v[3]); w.z = pk2(v[4], v[5]); w.w = pk2(v[6], v[7]); *(u32x4*)(KF + (size_t)tok * 768 + hd * 96 + 8 * m) = w; }
                    }
                }
            }
        }
        {
            const float* mkn = args.in[22];
            for (int idx = gw; idx < 512 * 4; idx += ngw) {
                const int row = idx >> 2, hd = idx & 3;
                const float a = MKV[(size_t)row * 1024 + hd * 128 + 2 * lane], b = MKV[(size_t)row * 1024 + hd * 128 + 2 * lane + 1];
                const float rk = __builtin_amdgcn_rsqf(wave_sum(a * a + b * b) * (1.0f / 128.0f) + EPS);
                ((unsigned*)(KM + (size_t)row * 512 + hd * 128))[lane] = pk2(a * rk * mkn[2 * lane], b * rk * mkn[2 * lane + 1]);
            }
            for (int i = gt; i < 2 * 4 * 128 * 256; i += ngt) { const int m = i & 255, d = (i >> 8) & 127, hd = (i >> 15) & 3, b = i >> 17;
                VMT[i] = (bf16_t)f2bf(MKV[(size_t)(b * 256 + m) * 1024 + 512 + hd * 128 + d]); }
        }
    }
    SEAM(5);
    if (IN(6)) DUP(6) { unsigned char* ws = opaque_ptr(args.ws);
        const int vcu = (G % 8 == 0) ? (bx % 8) * (G / 8) + bx / 8 : bx;
        float kbound;
        { const float* kng = args.in[18]; float gmx = fabsf(kng[lane]); if (lane < 32) gmx = fmaxf(gmx, fabsf(kng[64 + lane]));
#pragma unroll
          for (int o_ = 1; o_ < 64; o_ <<= 1) gmx = fmaxf(gmx, __shfl_xor(gmx, o_));
          kbound = gmx * 9.797958971f * 1.01f; }
#ifndef NO_MLA
        for (int p = vcu; p < 256; p += G) {
            const int bh = p >> 4, s = p & 15, b = bh >> 3, hd = bh & 7;
#pragma unroll 1
            for (int e = 0; e < 2; ++e) {
                const int qb = e == 0 ? 31 - s : s, q0 = qb * 256;
                attn_unit<96, 64, true, 128, true>(QRAW + ((size_t)(b * SEQ + q0)) * 768 + hd * 96, 768, KF + (size_t)b * SEQ * 768 + hd * 96, 768, VT + (size_t)(b * 8 + hd) * 64 * SEQ, SEQ,
                                        YB + ((size_t)(b * SEQ + q0)) * 512 + hd * 64, 512, q0, (q0 + 256) / 128, lds, kbound, args.in[17], positions + b * SEQ + q0, QSCALE_MLA);
            }
        }
#endif
#ifndef NO_MEMATT
        for (int p = bx; p < 256; p += G) {
            const int qb = p & 31, hd = (p >> 5) & 3, b = p >> 7, q0 = qb * 256;
            attn_unit<128, 128, false, 64, false>(QM + ((size_t)(b * SEQ + q0)) * 512 + hd * 128, 512, KM + (size_t)b * 256 * 512 + hd * 128, 512, VMT + (size_t)(b * 4 + hd) * 128 * 256, 256,
                                       YC + ((size_t)(b * SEQ + q0)) * 512 + hd * 128, 512, q0, 4, lds, 0.f, args.in[21], nullptr, QSCALE_MEM);
        }
#endif
    }
    SEAM(6);
    if (IN(7)) DUP(7) { unsigned char* ws = opaque_ptr(args.ws);
        pg8::Gemm g{X1B, wGT, T, NGATE, 1024}; pg8::StaticOrder S; S.init(T, NGATE, G, bx); EpiGate E{SS1, args.in[8], G0};
        pg8::gemm_phase<EpiGate, pg8::StaticOrder, true, true>(lds, g, S, E);
    }
    SEAM(7);
    if (IN(8)) DUP(8) { unsigned char* ws = opaque_ptr(args.ws);
        static_assert(B_YB - B_U == 16 * MiB && B_YC - B_YB == 16 * MiB && W_BB - W_BA == MiB && W_BC - W_BB == MiB, "branch operands contiguous");
        int kk = 512; asm volatile("" : "+s"(kk));
        pg8::Gemm g{U, wBA, 3 * T, 3072, kk}; BranchOrder S; S.base.init(T, 1024, G, bx); EpiBranch E{G0, MGO};
        pg8::gemm_phase<EpiBranch, BranchOrder, true, true>(lds, g, S, E);
    }
    SEAM(8);
    if (IN(9)) DUP(9) { unsigned char* ws = opaque_ptr(args.ws); const bool dry = rep_ < ((DUP_MASK >> 9) & 1);
        pg8::Gemm g{MGO, wOUT, T, 1024, 1024}; pg8::StaticOrder S; S.init(T, 1024, G, bx); EpiResid<true, true, false> E{nullptr, X1B, nullptr, X2B, dry ? (float*)(ws + S_DUMMY) : SS2, 1.0f};
        pg8::gemm_phase<EpiResid<true, true, false>, pg8::StaticOrder, true, true>(lds, g, S, E);
    }
    SEAM(9);
    if (IN(10)) DUP(10) { unsigned char* ws = opaque_ptr(args.ws);
        pg8::Gemm g{X2B, wGU2, T, 5632, 1024}; pg8::StaticOrder S; S.init(T, 5632, G, bx); EpiSwiglu<16> E{ACT, SS2};
        pg8::gemm_phase<EpiSwiglu<16>, pg8::StaticOrder, true, true>(lds, g, S, E);
    }
    SEAM(10);
    if (IN(11)) DUP(11) { unsigned char* ws = opaque_ptr(args.ws); const bool dry = rep_ < ((DUP_MASK >> 11) & 1);
        pg8::Gemm g{ACT, wDN2, T, 1024, FF}; pg8::StaticOrder S; S.init(T, 1024, G, bx); EpiResid<false, true, true> E{nullptr, X2B, out, nullptr, nullptr, 0.5f};
        pg8::gemm_phase<EpiResid<false, true, true>, pg8::StaticOrder, true, true>(lds, g, S, E);
    }
#undef IN
#undef SEAM
}

#ifndef N_LAUNCH_SPLIT
#define N_LAUNCH_SPLIT 0
#endif
extern "C" void kernel_launch(void* const* d_in, const int* in_sizes, int n_in, void* d_out, int out_size, void* d_ws, size_t ws_size, hipStream_t stream) {
    static int grid = 0;
    if (grid == 0) {
        if (n_in != 30 || out_size != T * DM || ws_size < WS_NEED) { fprintf(stderr, "kernel_launch: unexpected shapes (n_in %d out %d ws %zu)\n", n_in, out_size, ws_size); grid = -1; return; }
        int dev = 0, cus = 0, per_cu = 0;
        hipGetDevice(&dev); hipDeviceGetAttribute(&cus, hipDeviceAttributeMultiprocessorCount, dev);
        if (hipFuncSetAttribute((const void*)fwd_mega, hipFuncAttributeMaxDynamicSharedMemorySize, LDS_BYTES) != hipSuccess) { fprintf(stderr, "kernel_launch: hipFuncSetAttribute failed\n"); grid = -1; return; }
        if (hipOccupancyMaxActiveBlocksPerMultiprocessor(&per_cu, (const void*)fwd_mega, 512, LDS_BYTES) != hipSuccess || per_cu < 1) { fprintf(stderr, "kernel_launch: occupancy query says %d\n", per_cu); per_cu = 1; }
        (void)hipGetLastError();
        grid = cus * 1;
        if (grid > cus * per_cu) grid = cus * per_cu;
    }
    if (grid < 0) return;
    if (hipMemsetAsync((char*)d_ws + S_BAR, 0, XCD_BAR_WORDS * 4, stream) != hipSuccess) { fprintf(stderr, "kernel_launch: hipMemsetAsync of the barrier words failed\n"); return; }
    Args a{};
    for (int i = 0; i < 30; ++i) a.in[i] = (const float*)d_in[i];
    a.out = (float*)d_out; a.ws = (unsigned char*)d_ws;
#if N_LAUNCH_SPLIT
    for (int p = 0; p < NPH; ++p) { a.ph_lo = p; a.ph_hi = p + 1; void* kargs[] = {&a}; hipError_t e = hipLaunchCooperativeKernel((const void*)fwd_mega, dim3(grid), dim3(512), kargs, LDS_BYTES, stream);
        if (e != hipSuccess) { fprintf(stderr, "launch %d failed: %s\n", p, hipGetErrorString(e)); break; } }
#else
    a.ph_lo = 0; a.ph_hi = NPH; void* kargs[] = {&a};
    hipError_t e = hipLaunchCooperativeKernel((const void*)fwd_mega, dim3(grid), dim3(512), kargs, LDS_BYTES, stream);
    if (e != hipSuccess) fprintf(stderr, "cooperative launch failed: %s (grid %d)\n", hipGetErrorString(e), grid);
#endif
}
```

```cpp
#include <hip/hip_runtime.h>
#include <hip/hip_cooperative_groups.h>
#include <cstdio>
#include <cstdint>
namespace cg = cooperative_groups;
namespace pg8 {
#define PG8_LAS __attribute__((address_space(3)))
typedef unsigned short bf16_t;
typedef short bf16x8 __attribute__((ext_vector_type(8)));
typedef float f32x4 __attribute__((ext_vector_type(4)));
typedef unsigned u32x4 __attribute__((ext_vector_type(4)));
constexpr int BM = 256, BK = 64, HALF = 128, HTB = HALF * BK * 2  , STAGE_BYTES = 8 * HTB, NXCD = 8, WGM = 8;

__host__ __device__ __forceinline__ int lds_byte(int r, int c) { const int st = (r >> 4) * 2 + (c >> 5), rr = r & 15, cc = c & 31, ob = rr * 64 + cc * 2; return st * 1024 + (ob ^ (((ob >> 9) & 1) << 5)); }
__host__ __device__ __forceinline__ void stage_rc(int b, int& R, int& C) { const int st = b / 1024, sb = b % 1024, swz = sb ^ (((sb >> 9) & 1) << 5); R = (st >> 1) * 16 + swz / 64; C = (st & 1) * 32 + (swz % 64) / 2; }
__host__ __device__ __forceinline__ int perm32(int rho) { const int n = rho >> 4, i = rho & 15; return 8 * (i >> 2) + 4 * n + (i & 3); }

struct Unit { int pm, pn; };
struct Gemm { const bf16_t* A; const bf16_t* Bt; int M, N, K; };

struct StaticOrder {
    int nM, nN, nwg, G, c;
    __host__ __device__ void init(int M, int N, int G_, int c_) { nM = M / BM; nN = N / BM; nwg = nM * nN; G = G_; c = c_; }
    __host__ __device__ bool next(int i, Unit& u) const {
        const long L = (long)i * G + c; if (L >= nwg) return false;
        int wgid = (int)L; { const int q = nwg / NXCD, r = nwg % NXCD, xcd = wgid % NXCD, off = wgid / NXCD; wgid = (xcd < r ? xcd * (q + 1) : r * (q + 1) + (xcd - r) * q) + off; }
        const int nig = WGM * nN, gid = wgid / nig, fm = gid * WGM, gsz = (nM - fm) < WGM ? (nM - fm) : WGM;
        u.pm = fm + ((wgid % nig) % gsz); u.pn = (wgid % nig) / gsz; return true;
    }
    __device__ __forceinline__ void a_ready(const Unit&) const {}
    __device__ __forceinline__ void done(const Unit&) const {}
};
__device__ __forceinline__ unsigned cvt_pk_bf16(float lo, float hi) { unsigned r; asm volatile("v_cvt_pk_bf16_f32 %0, %1, %2" : "=v"(r) : "v"(lo), "v"(hi)); return r; }
typedef float f32x2 __attribute__((ext_vector_type(2)));
__device__ __forceinline__ f32x2 gelu_pk(f32x2 v) {
    const f32x2 av = __builtin_elementwise_abs(v), d = av * 0.2316418882f + 1.0f;
    f32x2 t; t.x = __builtin_amdgcn_rcpf(d.x); t.y = __builtin_amdgcn_rcpf(d.y);
    f32x2 q = t * 0.5307027145f + (-0.7265760135f); q = q * t + 0.7107068705f; q = q * t + (-0.142248368f); q = q * t + 0.127414796f; q = q * t;
    const f32x2 s = (v * v) * (-0.72134752044f);
    f32x2 e; e.x = __builtin_amdgcn_exp2f(s.x); e.y = __builtin_amdgcn_exp2f(s.y);
    const f32x2 m = v * (q * e), r = v - m;
    f32x2 o; o.x = v.x < 0.f ? m.x : r.x; o.y = v.y < 0.f ? m.y : r.y; return o;
}
template <class Epi, class Sched, bool ALIGN_EPI = false, bool SP2 = false>
__device__ __forceinline__ void gemm_phase(PG8_LAS unsigned char* lds, const Gemm g, const Sched& S, const Epi& E) {
    const int tid = threadIdx.x, wid = __builtin_amdgcn_readfirstlane(tid >> 6), lane = tid & 63, wr = wid >> 2, wc = wid & 3, fr = lane & 15, fq = lane >> 4;
    const int K = g.K, nt = K / BK;
    unsigned voffA[2], voffB[2];
#pragma unroll
    for (int i = 0; i < 2; ++i) { int R, C; stage_rc(tid * 16 + i * 8192, R, C); const int Rb = Epi::PERM ? ((R & ~31) + perm32(R & 31)) : R;
        voffA[i] = (unsigned)(R * K + C) * 2u; voffB[i] = (unsigned)(Rb * K + C) * 2u; }
    const size_t kstep = (size_t)(BK * 2);
    const size_t hstep = (size_t)HALF * K * 2;
    const size_t tstep = 2 * hstep;
    const unsigned ldsw = (unsigned)wid * 1024u;
    const int aoff = lds_byte(wr * 64 + fr, fq * 8), boff = lds_byte(wc * 32 + fr, fq * 8);
#define PG8_SA(b, h) (((b) * 2 + (h)) * HTB)
#define PG8_SB(b, h) ((4 + (b) * 2 + (h)) * HTB)
#define PG8_STAGE(bufoff, gbase, voff) do { _Pragma("unroll") for (int _i = 0; _i < 2; ++_i) \
        __builtin_amdgcn_global_load_lds((const unsigned*)((const char*)(gbase) + (voff)[_i]), (PG8_LAS unsigned*)(lds + (bufoff) + ldsw + _i * 8192), 16, 0, 0); } while (0)
#define PG8_LDA(dst, b, h) do { _Pragma("unroll") for (int m = 0; m < 4; ++m) _Pragma("unroll") for (int k = 0; k < 2; ++k) dst[m][k] = *(const PG8_LAS bf16x8*)(lds + PG8_SA(b, h) + aoff + m * 2048 + k * 1024); } while (0)
#define PG8_LDB(dst, b, h) do { _Pragma("unroll") for (int n = 0; n < 2; ++n) _Pragma("unroll") for (int k = 0; k < 2; ++k) dst[n][k] = *(const PG8_LAS bf16x8*)(lds + PG8_SB(b, h) + boff + n * 2048 + k * 1024); } while (0)
#define PG8_MMA(ai, bj, At, Bt) do { __builtin_amdgcn_s_setprio(1); _Pragma("unroll") for (int m = 0; m < 4; ++m) _Pragma("unroll") for (int n = 0; n < 2; ++n) _Pragma("unroll") for (int k = 0; k < 2; ++k) \
        acc[ai][bj][m][n] = __builtin_amdgcn_mfma_f32_16x16x32_bf16(Bt[n][k], At[m][k], acc[ai][bj][m][n], 0, 0, 0); __builtin_amdgcn_s_setprio(0); } while (0)
#define PG8_WAIT_V(n) asm volatile("s_waitcnt vmcnt(" #n ")" ::: "memory")
#define PG8_WAIT_L(n) asm volatile("s_waitcnt lgkmcnt(" #n ")" ::: "memory")
#define PG8_BAR __builtin_amdgcn_s_barrier()
#define PG8_SCHED __builtin_amdgcn_sched_barrier(0)
    Unit cur, nxt; int ui = 0;
    if (!S.next(0, cur)) return;
    f32x4 acc[2][2][4][2];
#pragma unroll
    for (int a = 0; a < 2; ++a)
#pragma unroll
        for (int b = 0; b < 2; ++b)
#pragma unroll
            for (int m = 0; m < 4; ++m)
#pragma unroll
                for (int n = 0; n < 2; ++n) acc[a][b][m][n] = (f32x4){0.f, 0.f, 0.f, 0.f};
    bf16x8 At[4][2], B0[2][2], B1[2][2];
    const char* cA = (const char*)g.A + (size_t)cur.pm * tstep; const char* cB = (const char*)g.Bt + (size_t)cur.pn * tstep;
    S.a_ready(cur);
    if constexpr (SP2) {
        PG8_STAGE(PG8_SB(0, 0), cB, voffB); PG8_STAGE(PG8_SB(0, 1), cB + hstep, voffB); PG8_STAGE(PG8_SA(0, 0), cA, voffA); PG8_STAGE(PG8_SA(0, 1), cA + hstep, voffA);
        if (wr == 1) PG8_BAR;
        PG8_WAIT_V(2); PG8_BAR;
        PG8_STAGE(PG8_SB(1, 0), cB + kstep, voffB); PG8_STAGE(PG8_SA(1, 0), cA + kstep, voffA); PG8_STAGE(PG8_SB(1, 1), cB + hstep + kstep, voffB);
        PG8_WAIT_V(6); PG8_BAR;
    } else {
        PG8_STAGE(PG8_SB(0, 0), cB, voffB); PG8_STAGE(PG8_SA(0, 0), cA, voffA); PG8_STAGE(PG8_SB(0, 1), cB + hstep, voffB); PG8_STAGE(PG8_SA(0, 1), cA + hstep, voffA);
        if (wr == 1) PG8_BAR;
        PG8_WAIT_V(4); PG8_BAR;
        PG8_STAGE(PG8_SB(1, 0), cB + kstep, voffB); PG8_STAGE(PG8_SA(1, 0), cA + kstep, voffA); PG8_STAGE(PG8_SB(1, 1), cB + hstep + kstep, voffB);
        PG8_WAIT_V(6); PG8_BAR;
    }
    for (;;) {
        const bool has_next = S.next(ui + 1, nxt);
        const char* nA = has_next ? (const char*)g.A + (size_t)nxt.pm * tstep : cA; const char* nB = has_next ? (const char*)g.Bt + (size_t)nxt.pn * tstep : cB;
        for (int t = 0; t < nt; t += 2) {
            const bool last = (t == nt - 2);
            const char* a1 = cA + (size_t)(t + 1) * kstep;
            const char* a2 = last ? nA : cA + (size_t)(t + 2) * kstep; const char* b2 = last ? nB : cB + (size_t)(t + 2) * kstep;
            const char* a3 = a2 + kstep; const char* b3 = b2 + kstep;
            if (last && has_next) S.a_ready(nxt);
            if constexpr (SP2) {
            PG8_LDB(B0, 0, 0); PG8_LDB(B1, 0, 1); PG8_SCHED; PG8_LDA(At, 0, 0); PG8_STAGE(PG8_SA(1, 1), a1 + hstep, voffA);
            PG8_WAIT_V(8); PG8_WAIT_L(0); PG8_BAR; PG8_MMA(0, 0, At, B0); PG8_MMA(0, 1, At, B1); PG8_BAR; PG8_SCHED;
            PG8_LDA(At, 0, 1); PG8_STAGE(PG8_SB(0, 0), b2, voffB); PG8_STAGE(PG8_SB(0, 1), b2 + hstep, voffB); PG8_STAGE(PG8_SA(0, 0), a2, voffA);
            PG8_WAIT_V(8); PG8_WAIT_L(0); PG8_BAR; PG8_MMA(1, 0, At, B0); PG8_MMA(1, 1, At, B1); PG8_BAR; PG8_SCHED;
            PG8_LDB(B0, 1, 0); PG8_LDB(B1, 1, 1); PG8_SCHED; PG8_LDA(At, 1, 0); PG8_STAGE(PG8_SA(0, 1), a2 + hstep, voffA);
            PG8_WAIT_V(8); PG8_WAIT_L(0); PG8_BAR; PG8_MMA(0, 0, At, B0); PG8_MMA(0, 1, At, B1); PG8_BAR; PG8_SCHED;
            PG8_LDA(At, 1, 1); PG8_STAGE(PG8_SB(1, 0), b3, voffB); PG8_STAGE(PG8_SB(1, 1), b3 + hstep, voffB); PG8_STAGE(PG8_SA(1, 0), a3, voffA);
            PG8_WAIT_V(8); PG8_WAIT_L(0); PG8_BAR; PG8_MMA(1, 0, At, B0); PG8_MMA(1, 1, At, B1); PG8_BAR; PG8_SCHED;
            } else {
            PG8_LDB(B0, 0, 0); PG8_SCHED; PG8_LDA(At, 0, 0); PG8_STAGE(PG8_SA(1, 1), a1 + hstep, voffA);
            PG8_WAIT_L(8); PG8_BAR; PG8_WAIT_L(0); PG8_MMA(0, 0, At, B0); PG8_BAR; PG8_SCHED;
            PG8_LDB(B1, 0, 1); PG8_STAGE(PG8_SB(0, 0), b2, voffB);
            PG8_BAR; PG8_WAIT_L(0); PG8_MMA(0, 1, At, B1); PG8_BAR;
            PG8_LDA(At, 0, 1); PG8_STAGE(PG8_SA(0, 0), a2, voffA);
            PG8_BAR; PG8_WAIT_L(0); PG8_MMA(1, 0, At, B0); PG8_BAR; PG8_SCHED;
            PG8_STAGE(PG8_SB(0, 1), b2 + hstep, voffB);
            PG8_WAIT_V(6); PG8_BAR; PG8_MMA(1, 1, At, B1); PG8_BAR;
            PG8_LDB(B0, 1, 0); PG8_SCHED; PG8_LDA(At, 1, 0); PG8_STAGE(PG8_SA(0, 1), a2 + hstep, voffA);
            PG8_WAIT_L(8); PG8_BAR; PG8_WAIT_L(0); PG8_MMA(0, 0, At, B0); PG8_BAR; PG8_SCHED;
            PG8_LDB(B1, 1, 1); PG8_STAGE(PG8_SB(1, 0), b3, voffB);
            PG8_BAR; PG8_WAIT_L(0); PG8_MMA(0, 1, At, B1); PG8_BAR;
            PG8_LDA(At, 1, 1); PG8_STAGE(PG8_SA(1, 0), a3, voffA);
            PG8_BAR; PG8_WAIT_L(0); PG8_MMA(1, 0, At, B0); PG8_BAR; PG8_SCHED;
            PG8_STAGE(PG8_SB(1, 1), b3 + hstep, voffB);
            PG8_WAIT_V(6); PG8_BAR; PG8_MMA(1, 1, At, B1); PG8_BAR;
            }
        }
        if constexpr (ALIGN_EPI) { if (wr == 0) PG8_BAR; }
        if constexpr (!Epi::AFTER_DRAIN) { E(acc, cur, wr, wc, fr, fq); S.done(cur); }
        if (!has_next) break;
#pragma unroll
        for (int a = 0; a < 2; ++a)
#pragma unroll
            for (int b = 0; b < 2; ++b)
#pragma unroll
                for (int m = 0; m < 4; ++m)
#pragma unroll
                    for (int n = 0; n < 2; ++n) acc[a][b][m][n] = (f32x4){0.f, 0.f, 0.f, 0.f};
        cur = nxt; cA = nA; cB = nB; ++ui;
        if constexpr (ALIGN_EPI) { if (wr == 1) PG8_BAR; }
    }
    PG8_WAIT_V(0);
    if constexpr (!ALIGN_EPI) { if (wr == 0) PG8_BAR; }
    PG8_BAR;
    if constexpr (Epi::AFTER_DRAIN) { E.fused(acc, cur, wr, wc, fr, fq, lds, wid, lane); S.done(cur); }
#undef PG8_SA
#undef PG8_SB
#undef PG8_STAGE
#undef PG8_LDA
#undef PG8_LDB
#undef PG8_MMA
#undef PG8_WAIT_V
#undef PG8_WAIT_L
#undef PG8_BAR
#undef PG8_SCHED
}
}

#define DI __device__ __forceinline__
#define LAS __attribute__((address_space(3)))
using pg8::bf16_t; using pg8::f32x4; using pg8::bf16x8; using pg8::u32x4; using pg8::Unit; using pg8::f32x2;
typedef float f32x16 __attribute__((ext_vector_type(16)));
typedef short s16x4 __attribute__((ext_vector_type(4)));
typedef unsigned u32x2 __attribute__((ext_vector_type(2)));

constexpr int T = 16384, SEQ = 8192, DM = 1024, FF = 2816;
constexpr int NWIN = 2304, NGATE = 3072;
constexpr float EPS = 1e-6f;
constexpr float LOG2E = 1.4426950408889634f;
constexpr float QSCALE_MLA = 0.10206207261596575f * LOG2E;
constexpr float QSCALE_MEM = 0.08838834764831845f * LOG2E;

constexpr size_t MiB = 1u << 20;
constexpr size_t W_GU1 = 0, W_DN1 = 11 * MiB, W_IN = W_DN1 + 5632 * 1024, W_GT = W_IN + (size_t)NWIN * 2048, W_UQ = 27 * MiB + 512 * 1024, W_UKV = 28 * MiB + 512 * 1024,
                 W_MKV = 29 * MiB, W_BA = 31 * MiB, W_BB = 32 * MiB, W_BC = 33 * MiB, W_OUT = 34 * MiB, W_GU2 = 36 * MiB, W_DN2 = 47 * MiB, W_SG = 53 * MiB;
static_assert(W_GT + (size_t)NGATE * 2048 <= W_UQ && W_UQ + 768 * 384 * 2 <= W_UKV && W_DN2 + 5632 * 1024 <= W_SG, "weight map");
constexpr size_t S_SS1 = 54 * MiB, S_SS2 = 55 * MiB, S_VST = 56 * MiB, S_CQP = 58 * MiB, S_CKVP = 59 * MiB, S_QMP = 60 * MiB, S_KR = 61 * MiB,
                 S_MEMN = 63 * MiB, S_MKV = 64 * MiB, S_KM = 66 * MiB, S_VMT = 66 * MiB + 512 * 1024;
constexpr size_t S_BAR = 53 * MiB + 512 * 1024;
constexpr size_t S_R0 = 53 * MiB + 384 * 1024;
constexpr size_t S_DUMMY = 53 * MiB + 256 * 1024;
constexpr size_t BIG = 67 * MiB;
constexpr size_t B_X1B = BIG, B_MG = BIG, B_U = BIG + 32 * MiB, B_YB = BIG + 48 * MiB, B_YC = BIG + 64 * MiB, B_VG = BIG + 48 * MiB, B_CQ = BIG + 64 * MiB, B_CKV = BIG + 76 * MiB,
                 B_QM = BIG + 84 * MiB, B_QRAW = BIG + 100 * MiB, B_K = BIG + 124 * MiB, B_VT = BIG + 148 * MiB, B_KN = BIG + 164 * MiB,
                 B_G0 = BIG + 80 * MiB, B_G1 = BIG + 112 * MiB, B_G2 = BIG + 144 * MiB, B_ACT = BIG + 32 * MiB, B_XB = BIG + 120 * MiB, B_X2B = BIG + 120 * MiB;
static_assert(B_G1 - B_G0 == 32 * MiB && B_G2 - B_G1 == 32 * MiB, "gate buffers 32 MiB apart");
constexpr size_t WS_NEED = BIG + 184 * MiB;

DI unsigned f2bf(float f) { unsigned u = __builtin_bit_cast(unsigned, f); return (u + 0x7fffu + ((u >> 16) & 1u)) >> 16; }
DI unsigned pk2(float lo, float hi) { typedef float v2f __attribute__((ext_vector_type(2))); typedef __bf16 v2b __attribute__((ext_vector_type(2))); v2f v = {lo, hi}; v2b b = __builtin_convertvector(v, v2b); return __builtin_bit_cast(unsigned, b); }
DI float bflo(unsigned w) { return __uint_as_float(w << 16); }
DI float bfhi(unsigned w) { return __uint_as_float(w & 0xffff0000u); }
DI float sigmoidf_(float v) { return __builtin_amdgcn_rcpf(1.0f + __expf(-v)); }
DI float siluf_(float v) { return v * sigmoidf_(v); }

template <int NP> DI float row_rstd(const float* P, int row, float invn) {
    if (NP == 0) return 1.0f;
    return __builtin_amdgcn_rsqf(P[row] * invn + EPS);
}
DI void atomic_addf(float* p, float v) { __builtin_amdgcn_global_atomic_fadd_f32((__attribute__((address_space(1))) float*)p, v); }
DI float quad_sum(float s) { s += __shfl_xor(s, 16); s += __shfl_xor(s, 32); return s; }

template <int NP> struct EpiSwiglu {
    static constexpr bool PERM = true, AFTER_DRAIN = false;
    bf16_t* O; const float* P;
    DI void operator()(const f32x4 (&acc)[2][2][4][2], const Unit& u, int wr, int wc, int fr, int fq) const {
        const int row0 = u.pm * 256 + wr * 64 + fr, col0 = u.pn * 128 + wc * 32 + 8 * fq;
#pragma unroll
        for (int ai = 0; ai < 2; ++ai)
#pragma unroll
            for (int m = 0; m < 4; ++m) {
                const int row = row0 + ai * 128 + m * 16; const float rs = row_rstd<NP>(P, row, 1.0f / 1024.0f);
                float a[8];
#pragma unroll
                for (int n = 0; n < 2; ++n)
#pragma unroll
                    for (int i = 0; i < 4; ++i) { const float g = acc[ai][0][m][n][i] * rs, uu = acc[ai][1][m][n][i] * rs; a[4 * n + i] = siluf_(g) * uu; }
                u32x4 w; w.x = pk2(a[0], a[1]); w.y = pk2(a[2], a[3]); w.z = pk2(a[4], a[5]); w.w = pk2(a[6], a[7]);
                *(u32x4*)(O + (size_t)row * FF + col0) = w;
            }
    }
};
template <bool WB, bool B16, bool WOUT> struct EpiResid {
    static constexpr bool PERM = true, AFTER_DRAIN = false;
    const float* base  ; const bf16_t* base16; float* out; bf16_t* xb; float* P; float alpha;
    DI void operator()(const f32x4 (&acc)[2][2][4][2], const Unit& u, int wr, int wc, int fr, int fq) const {
        const int row0 = u.pm * 256 + wr * 64 + fr, col0 = u.pn * 256 + wc * 32 + 8 * fq;
#pragma unroll
        for (int ai = 0; ai < 2; ++ai)
#pragma unroll
            for (int m = 0; m < 4; ++m) {
                const int row = row0 + ai * 128 + m * 16; float ss = 0.f;
                const float bs = (B16 && base) ? base[row] : 1.0f;
#pragma unroll
                for (int bj = 0; bj < 2; ++bj) {
                    const size_t off = (size_t)row * DM + col0 + bj * 128;
                    f32x4 b0, b1;
                    if (B16) { const u32x4 bb = *(const u32x4*)(base16 + off); b0 = (f32x4){bflo(bb.x), bfhi(bb.x), bflo(bb.y), bfhi(bb.y)}; b1 = (f32x4){bflo(bb.z), bfhi(bb.z), bflo(bb.w), bfhi(bb.w)}; b0 = b0 * bs; b1 = b1 * bs; }
                    else { b0 = *(const f32x4*)(base + off); b1 = *(const f32x4*)(base + off + 4); }
                    const f32x4 o0 = b0 + acc[ai][bj][m][0] * alpha, o1 = b1 + acc[ai][bj][m][1] * alpha;
                    if (WOUT) { *(f32x4*)(out + off) = o0; *(f32x4*)(out + off + 4) = o1; }
                    if (WB) { ss += (o0[0] * o0[0] + o0[1] * o0[1]) + (o0[2] * o0[2] + o0[3] * o0[3]) + (o1[0] * o1[0] + o1[1] * o1[1]) + (o1[2] * o1[2] + o1[3] * o1[3]);
                        u32x4 w; w.x = pk2(o0[0], o0[1]); w.y = pk2(o0[2], o0[3]); w.z = pk2(o1[0], o1[1]); w.w = pk2(o1[2], o1[3]); *(u32x4*)(xb + off) = w; }
                }
                if (WB) { ss = quad_sum(ss); if (fq == 0) atomic_addf(P + row, ss); }
            }
    }
};
struct EpiWin {
    static constexpr bool PERM = true, AFTER_DRAIN = false;
    const float* P; bf16_t *U, *Vg, *CQ, *CKV, *QM; float *KR, *VST, *CQP, *CKVP, *QMP;
    DI void operator()(const f32x4 (&acc)[2][2][4][2], const Unit& u, int wr, int wc, int fr, int fq) const {
        const int row0 = u.pm * 256 + wr * 64 + fr, cw = wc * 32 + 8 * fq;
#pragma unroll
        for (int ai = 0; ai < 2; ++ai)
#pragma unroll
            for (int m = 0; m < 4; ++m) {
                const int row = row0 + ai * 128 + m * 16; const float rs = row_rstd<16>(P, row, 1.0f / 1024.0f);
#pragma unroll
                for (int bj = 0; bj < 2; ++bj) {
                    const int c128 = u.pn * 256 + bj * 128;
                    float v[8];
#pragma unroll
                    for (int n = 0; n < 2; ++n)
#pragma unroll
                        for (int i = 0; i < 4; ++i) v[4 * n + i] = acc[ai][bj][m][n][i] * rs;
                    if (c128 < 1024) {
#pragma unroll
                        for (int i = 0; i < 8; i += 2) { const f32x2 g = pg8::gelu_pk((f32x2){v[i], v[i + 1]}); v[i] = g.x; v[i + 1] = g.y; }
                        const bool isv = c128 >= 512;
                        u32x4 w; w.x = pk2(v[0], v[1]); w.y = pk2(v[2], v[3]); w.z = pk2(v[4], v[5]); w.w = pk2(v[6], v[7]);
                        *(u32x4*)((isv ? Vg : U) + (size_t)row * 512 + (c128 & 511) + cw) = w;
                        if (isv) {
                            float s1 = 0.f, s2 = 0.f;
#pragma unroll
                            for (int i = 0; i < 8; ++i) { s1 += v[i]; s2 += v[i] * v[i]; }
                            s1 = quad_sum(s1); s2 = quad_sum(s2);
                            if (fq == 0) { float* d = VST + ((size_t)row * 16 + ((c128 - 512) >> 7) * 4 + wc) * 2; d[0] = s1; d[1] = s2; }
                        }
                    } else if (c128 < 2176) {
                        bf16_t* dst; float* pp; const bool isqm = c128 >= 1664;
                        if (c128 < 1408) { dst = CQ + (size_t)row * 384 + (c128 - 1024); pp = CQP + row; }
                        else if (c128 < 1664) { dst = CKV + (size_t)row * 256 + (c128 - 1408); pp = CKVP + row; }
                        else { dst = QM + (size_t)row * 512 + (c128 - 1664); pp = QMP + (size_t)row * 16 + ((c128 - 1664) >> 7) * 4 + wc; }
                        u32x4 w; w.x = pk2(v[0], v[1]); w.y = pk2(v[2], v[3]); w.z = pk2(v[4], v[5]); w.w = pk2(v[6], v[7]);
                        *(u32x4*)(dst + cw) = w;
                        float s2 = 0.f;
#pragma unroll
                        for (int i = 0; i < 8; ++i) s2 += v[i] * v[i];
                        s2 = quad_sum(s2);
                        if (fq == 0) { if (isqm) *pp = s2; else atomic_addf(pp, s2); }
                    } else if (c128 == 2176) {
                        if (wc == 0) { float* d = KR + (size_t)row * 32 + 8 * fq; *(f32x4*)d = (f32x4){v[0], v[1], v[2], v[3]}; *(f32x4*)(d + 4) = (f32x4){v[4], v[5], v[6], v[7]}; }
                    }
                }
            }
    }
};
struct EpiGate {
    static constexpr bool PERM = true, AFTER_DRAIN = false;
    const float* P; const float* bias; bf16_t* G0;
    DI void operator()(const f32x4 (&acc)[2][2][4][2], const Unit& u, int wr, int wc, int fr, int fq) const {
        const int row0 = u.pm * 256 + wr * 64 + fr, br = u.pn >> 2, cw = (u.pn & 3) * 256 + wc * 32 + 8 * fq;
        bf16_t* G = G0 + (size_t)br * (16u << 20);
        f32x4 bv[2][2];
#pragma unroll
        for (int bj = 0; bj < 2; ++bj)
#pragma unroll
            for (int n = 0; n < 2; ++n) bv[bj][n] = *(const f32x4*)(bias + br * 1024 + cw + bj * 128 + 4 * n);
#pragma unroll
        for (int ai = 0; ai < 2; ++ai)
#pragma unroll
            for (int m = 0; m < 4; ++m) {
                const int row = row0 + ai * 128 + m * 16; const float rs = row_rstd<16>(P, row, 1.0f / 1024.0f);
#pragma unroll
                for (int bj = 0; bj < 2; ++bj) {
                    float v[8];
#pragma unroll
                    for (int n = 0; n < 2; ++n)
#pragma unroll
                        for (int i = 0; i < 4; ++i) v[4 * n + i] = sigmoidf_(acc[ai][bj][m][n][i] * rs + bv[bj][n][i]);
                    u32x4 w; w.x = pk2(v[0], v[1]); w.y = pk2(v[2], v[3]); w.z = pk2(v[4], v[5]); w.w = pk2(v[6], v[7]);
                    *(u32x4*)(G + (size_t)row * DM + cw + bj * 128) = w;
                }
            }
    }
};
struct EpiUq {
    static constexpr bool PERM = true, AFTER_DRAIN = false;
    const float* P; bf16_t* O;
    DI void operator()(const f32x4 (&acc)[2][2][4][2], const Unit& u, int wr, int wc, int fr, int fq) const {
        const int row0 = u.pm * 256 + wr * 64 + fr, cw = u.pn * 256 + wc * 32 + 8 * fq;
#pragma unroll
        for (int ai = 0; ai < 2; ++ai)
#pragma unroll
            for (int m = 0; m < 4; ++m) {
                const int row = row0 + ai * 128 + m * 16; const float rs = row_rstd<1>(P, row, 1.0f / 384.0f);
#pragma unroll
                for (int bj = 0; bj < 2; ++bj) {
                    const f32x4 a = acc[ai][bj][m][0] * rs, b = acc[ai][bj][m][1] * rs;
                    u32x4 w; w.x = pk2(a[0], a[1]); w.y = pk2(a[2], a[3]); w.z = pk2(b[0], b[1]); w.w = pk2(b[2], b[3]);
                    *(u32x4*)(O + (size_t)row * 768 + cw + bj * 128) = w;
                }
            }
    }
};
struct EpiUkv {
    static constexpr bool PERM = true, AFTER_DRAIN = false;
    const float* P; bf16_t* KN; bf16_t* Vt;
    DI void operator()(const f32x4 (&acc)[2][2][4][2], const Unit& u, int wr, int wc, int fr, int fq) const {
        const int row0 = u.pm * 256 + wr * 64 + fr;
#pragma unroll
        for (int ai = 0; ai < 2; ++ai)
#pragma unroll
            for (int m = 0; m < 4; ++m) {
                const int row = row0 + ai * 128 + m * 16; const float rs = row_rstd<1>(P, row, 1.0f / 256.0f);
                const int b = row >> 13, s = row & 8191;
#pragma unroll
                for (int bj = 0; bj < 2; ++bj) {
                    const int h = u.pn * 2 + bj;
                    const f32x4 a = acc[ai][bj][m][0] * rs, c = acc[ai][bj][m][1] * rs;
                    if (wc < 2) {
                        u32x4 w; w.x = pk2(a[0], a[1]); w.y = pk2(a[2], a[3]); w.z = pk2(c[0], c[1]); w.w = pk2(c[2], c[3]);
                        *(u32x4*)(KN + (size_t)row * 512 + h * 64 + wc * 32 + 8 * fq) = w;
                    } else {
                        const unsigned vo = (unsigned)((b * 8 + h) * 64 + (wc - 2) * 32 + 8 * fq) * (unsigned)SEQ + (unsigned)s;
#pragma unroll
                        for (int i = 0; i < 4; ++i) { Vt[vo + (unsigned)(i * SEQ)] = (bf16_t)f2bf(a[i]); Vt[vo + (unsigned)((4 + i) * SEQ)] = (bf16_t)f2bf(c[i]); }
                    }
                }
            }
    }
};
struct EpiF32 {
    static constexpr bool PERM = true, AFTER_DRAIN = false;
    float* O; int ldc;
    DI void operator()(const f32x4 (&acc)[2][2][4][2], const Unit& u, int wr, int wc, int fr, int fq) const {
        const int row0 = u.pm * 256 + wr * 64 + fr, col0 = u.pn * 256 + wc * 32 + 8 * fq;
#pragma unroll
        for (int ai = 0; ai < 2; ++ai)
#pragma unroll
            for (int m = 0; m < 4; ++m)
#pragma unroll
                for (int bj = 0; bj < 2; ++bj)
#pragma unroll
                    for (int n = 0; n < 2; ++n) *(f32x4*)(O + (size_t)(row0 + ai * 128 + m * 16) * ldc + col0 + bj * 128 + n * 4) = acc[ai][bj][m][n];
    }
};
struct GateOrder {
    pg8::StaticOrder base;
    __device__ bool next(int i, Unit& u) const { Unit b; if (!base.next(i / 3, b)) return false; u.pm = b.pm; u.pn = b.pn + 4 * (i % 3); return true; }
    DI void a_ready(const Unit&) const {}
    DI void done(const Unit&) const {}
};
struct BranchOrder {
    pg8::StaticOrder base;
    __device__ bool next(int i, Unit& u) const { Unit b; if (!base.next(i / 3, b)) return false; const int br = i % 3; u.pm = b.pm + 64 * br; u.pn = b.pn + 4 * br; return true; }
    DI void a_ready(const Unit&) const {}
    DI void done(const Unit&) const {}
};
struct EpiBranch {
    static constexpr bool PERM = true, AFTER_DRAIN = false;
    const bf16_t* G0; bf16_t* MG;
    DI void operator()(const f32x4 (&acc)[2][2][4][2], const Unit& u, int wr, int wc, int fr, int fq) const {
        const int br = u.pm >> 6, row0 = (u.pm & 63) * 256 + wr * 64 + fr, col0 = (u.pn & 3) * 256 + wc * 32 + 8 * fq;
        const bf16_t* G = G0 + (size_t)br * (16u << 20);
#pragma unroll
        for (int ai = 0; ai < 2; ++ai)
#pragma unroll
            for (int m = 0; m < 4; ++m)
#pragma unroll
                for (int bj = 0; bj < 2; ++bj) {
                    const size_t off = (size_t)(row0 + ai * 128 + m * 16) * DM + col0 + bj * 128;
                    const u32x4 g = *(const u32x4*)(G + off); const f32x4 a = acc[ai][bj][m][0], b = acc[ai][bj][m][1];
                    float o[8] = {bflo(g.x) * a[0], bfhi(g.x) * a[1], bflo(g.y) * a[2], bfhi(g.y) * a[3], bflo(g.z) * b[0], bfhi(g.z) * b[1], bflo(g.w) * b[2], bfhi(g.w) * b[3]};
                    if (br > 0) { const u32x4 p = *(const u32x4*)(MG + off); o[0] += bflo(p.x); o[1] += bfhi(p.x); o[2] += bflo(p.y); o[3] += bfhi(p.y); o[4] += bflo(p.z); o[5] += bfhi(p.z); o[6] += bflo(p.w); o[7] += bfhi(p.w); }
                    u32x4 w; w.x = pk2(o[0], o[1]); w.y = pk2(o[2], o[3]); w.z = pk2(o[4], o[5]); w.w = pk2(o[6], o[7]); *(u32x4*)(MG + off) = w;
                }
    }
};

__constant__ float ROPE_INV[16] = {1.0f, 0.5623413324356079f, 0.3162277638912201f, 0.17782793939113617f, 0.10000000149011612f, 0.05623413249850273f, 0.03162277489900589f, 0.017782794311642647f,
                                   0.009999999776482582f, 0.005623413249850273f, 0.003162277629598975f, 0.0017782794311642647f, 0.0010000000474974513f, 0.000562341301701963f, 0.0003162277571391314f, 0.00017782794020604342f};
#define MFMA32(a, b, c) __builtin_amdgcn_mfma_f32_32x32x16_bf16((a), (b), (c), 0, 0, 0)
DI float xhalf_max(float m) { auto rr = __builtin_amdgcn_permlane32_swap(__float_as_uint(m), __float_as_uint(m), false, false); return __builtin_fmaxf(__uint_as_float(rr[0]), __uint_as_float(rr[1])); }
DI float xhalf_sum(float m) { auto rr = __builtin_amdgcn_permlane32_swap(__float_as_uint(m), __float_as_uint(m), false, false); return __uint_as_float(rr[0]) + __uint_as_float(rr[1]); }
template <int DQK, int DV, bool CAUSAL, int KT, bool PRIO>
DI void attn_unit(const bf16_t* Qb, int qpitch, const bf16_t* Kb, int kpitch, const bf16_t* Vtb, int vpitch, bf16_t* Ob, int opitch, int q0, int nt, LAS unsigned char* lds, float kbound, const float* qgain, const int* qpos, float qscale) {
    constexpr int KS = DQK * 2 + 16, VS = KT * 2 + 8, KBUF = KT * KS, VBUF = DV * VS, VOFF = 2 * KBUF;
    constexpr int KCH = DQK / 8, NKC = KT * KCH, NKR = (NKC + 511) / 512, VCH = KT / 8, NVC = DV * VCH, NVR = NVC / 512;
    constexpr float THR = 8.0f;
    static_assert(NVC % 512 == 0 && VOFF + 2 * VBUF <= 131072, "attention staging geometry");
    int tid_ = threadIdx.x; asm volatile("" : "+v"(tid_));
    const int tid = tid_, lane = tid & 63, r = lane & 31, h = lane >> 5, w = __builtin_amdgcn_readfirstlane(tid >> 6);
    u32x4 kreg[NKR], vreg[NVR];
    auto gload = [&](int kt) {
#pragma unroll
        for (int i = 0; i < NKR; ++i) { const int c = tid + i * 512; if (NKC % 512 == 0 || c < NKC) kreg[i] = *(const u32x4*)(Kb + (size_t)(kt * KT + c / KCH) * kpitch + (c % KCH) * 8); }
#pragma unroll
        for (int i = 0; i < NVR; ++i) { const int c = tid + i * 512; vreg[i] = *(const u32x4*)(Vtb + (size_t)(c / VCH) * vpitch + kt * KT + (c % VCH) * 8); }
    };
    auto lstore = [&](int buf) {
#pragma unroll
        for (int i = 0; i < NKR; ++i) { const int c = tid + i * 512; if (NKC % 512 == 0 || c < NKC) *(LAS u32x4*)(lds + buf * KBUF + (c / KCH) * KS + (c % KCH) * 16) = kreg[i]; }
#pragma unroll
        for (int i = 0; i < NVR; ++i) { const int c = tid + i * 512; LAS unsigned char* p = lds + VOFF + buf * VBUF + (c / VCH) * VS + (c % VCH) * 16;
            *(LAS u32x2*)p = (u32x2){vreg[i].x, vreg[i].y}; *(LAS u32x2*)(p + 8) = (u32x2){vreg[i].z, vreg[i].w}; }
    };
    gload(0);
    bf16x8 qf[DQK / 16];
#pragma unroll
    for (int ks = 0; ks < DQK / 16; ++ks) qf[ks] = *(const bf16x8*)(Qb + (size_t)(32 * w + r) * qpitch + 16 * ks + 8 * h);
    if (qgain) {
        float v[DQK / 16][8]; float q2 = 0.f;
#pragma unroll
        for (int ks = 0; ks < DQK / 16; ++ks)
#pragma unroll
            for (int e = 0; e < 8; ++e) { v[ks][e] = __uint_as_float(((unsigned)(unsigned short)qf[ks][e]) << 16); q2 += v[ks][e] * v[ks][e]; }
        q2 = xhalf_sum(q2);
        const float rq = __builtin_amdgcn_rsqf(q2 * (1.0f / (float)DQK) + EPS) * qscale;
#pragma unroll
        for (int ks = 0; ks < DQK / 16; ++ks) { const f32x4 g0 = *(const f32x4*)(qgain + 16 * ks + 8 * h), g1 = *(const f32x4*)(qgain + 16 * ks + 8 * h + 4);
#pragma unroll
            for (int e = 0; e < 4; ++e) { v[ks][e] *= rq * g0[e]; v[ks][4 + e] *= rq * g1[e]; } }
        if (DQK == 96 && qpos) {
        const float pos = (float)qpos[32 * w + r];
#pragma unroll
        for (int e = 0; e < 8; ++e) {
            const float ang = pos * ROPE_INV[8 * h + e]; const double rev = (double)ang * 0.15915494309189535; const float f = (float)(rev - floor(rev));
            const float c = __builtin_amdgcn_cosf(f), sn_ = __builtin_amdgcn_sinf(f), x1 = v[4][e], x2 = v[5][e];
            v[4][e] = x1 * c - x2 * sn_; v[5][e] = x2 * c + x1 * sn_; }
        }
#pragma unroll
        for (int ks = 0; ks < DQK / 16; ++ks) { u32x4 pw; pw.x = pk2(v[ks][0], v[ks][1]); pw.y = pk2(v[ks][2], v[ks][3]); pw.z = pk2(v[ks][4], v[ks][5]); pw.w = pk2(v[ks][6], v[ks][7]); qf[ks] = __builtin_bit_cast(bf16x8, pw); }
    }
    f32x16 o[DV / 32], negm;
#pragma unroll
    for (int i = 0; i < 16; ++i) negm[i] = 0.f;
#pragma unroll
    for (int d = 0; d < DV / 32; ++d)
#pragma unroll
        for (int i = 0; i < 16; ++i) o[d][i] = 0.f;
    float mrun = 0.f, lrun = 0.f; bool first = true;
    bool nomax = false;
    if (PRIO) {
        float q2 = 0.f;
#pragma unroll
        for (int ks = 0; ks < DQK / 16; ++ks)
#pragma unroll
            for (int e = 0; e < 8; ++e) { const float v = __uint_as_float(((unsigned)(unsigned short)qf[ks][e]) << 16); q2 += v * v; }
        q2 = xhalf_sum(q2);
        nomax = __all(sqrtf(q2) * kbound <= 100.0f) != 0;
    }
    lstore(0);
    __syncthreads();
    const int qabs = q0 + 32 * w + r, qlo = q0 + 32 * w;
    for (int kt = 0; kt < nt; ++kt) {
        const int buf = kt & 1;
        if (kt + 1 < nt) gload(kt + 1);
#pragma unroll
        for (int hf = 0; hf < KT / 64; ++hf) {
            const int key0 = kt * KT + 64 * hf;
            if (!CAUSAL || key0 <= qlo + 31) {
                if (PRIO) {
                    constexpr int KSN = DQK / 16, NDB = DV / 32;
                    f32x16 s0 = negm, s1 = negm;
                    const LAS unsigned char* kb = lds + buf * KBUF + (64 * hf + r) * KS + h * 16;
                    const LAS unsigned char* vb = lds + VOFF + buf * VBUF + r * VS + h * 8 + 128 * hf;
                    bf16x8 kf0[KSN], kf1[KSN], vf[4][NDB];
#pragma unroll
                    for (int ks = 0; ks < KSN; ++ks) { kf0[ks] = *(const LAS bf16x8*)(kb + ks * 32); kf1[ks] = *(const LAS bf16x8*)(kb + 32 * KS + ks * 32); }
                    __builtin_amdgcn_sched_barrier(0); __builtin_amdgcn_s_setprio(1); __builtin_amdgcn_sched_barrier(0);
#pragma unroll
                    for (int ks = 0; ks < KSN; ++ks) { s0 = MFMA32(kf0[ks], qf[ks], s0); s1 = MFMA32(kf1[ks], qf[ks], s1); }
                    __builtin_amdgcn_sched_barrier(0); __builtin_amdgcn_s_setprio(0); __builtin_amdgcn_sched_barrier(0);
#pragma unroll
                    for (int q4 = 0; q4 < 4; ++q4)
#pragma unroll
                        for (int d = 0; d < NDB; ++d) { const LAS unsigned char* vp = vb + d * 32 * VS + q4 * 32;
                            const s16x4 lo = *(const LAS s16x4*)vp, hi = *(const LAS s16x4*)(vp + 16); vf[q4][d] = (bf16x8){lo[0], lo[1], lo[2], lo[3], hi[0], hi[1], hi[2], hi[3]}; }
                    if (CAUSAL && key0 + 63 > qlo) {
#pragma unroll
                        for (int i = 0; i < 16; ++i) { const int key = key0 + (i & 3) + 8 * (i >> 2) + 4 * h; if (key > qabs) s0[i] = -1e30f; if (key + 32 > qabs) s1[i] = -1e30f; }
                    }
                    if (!nomax) {
                    float ra = __builtin_fmaxf(__builtin_fmaxf(s0[0], s0[1]), s1[0]), rb = __builtin_fmaxf(__builtin_fmaxf(s0[2], s0[3]), s1[1]);
                    ra = __builtin_fmaxf(__builtin_fmaxf(ra, s1[2]), s1[3]);
#pragma unroll
                    for (int i = 4; i < 16; i += 4) { ra = __builtin_fmaxf(__builtin_fmaxf(ra, s0[i]), s0[i + 1]); rb = __builtin_fmaxf(__builtin_fmaxf(rb, s0[i + 2]), s0[i + 3]);
                        ra = __builtin_fmaxf(__builtin_fmaxf(ra, s1[i]), s1[i + 1]); rb = __builtin_fmaxf(__builtin_fmaxf(rb, s1[i + 2]), s1[i + 3]); }
                    float rm = __builtin_fmaxf(ra, rb);
                    rm = xhalf_max(rm);
                    if (first || __any(rm > THR)) {
                        const float dl = first ? rm : fmaxf(rm, 0.f), f = __builtin_amdgcn_exp2f(-dl);
                        mrun += dl; lrun *= f; first = false;
#pragma unroll
                        for (int i = 0; i < 16; ++i) { s0[i] -= dl; s1[i] -= dl; negm[i] = -mrun; }
#pragma unroll
                        for (int d = 0; d < NDB; ++d)
#pragma unroll
                            for (int i = 0; i < 16; ++i) o[d][i] *= f;
                    }
                    }
                    float ps = 0.f;
#pragma unroll
                    for (int i = 0; i < 16; ++i) { s0[i] = __builtin_amdgcn_exp2f(s0[i]); ps += s0[i]; asm volatile("" : "+v"(ps)); }
#pragma unroll
                    for (int i = 0; i < 16; ++i) { s1[i] = __builtin_amdgcn_exp2f(s1[i]); ps += s1[i]; asm volatile("" : "+v"(ps)); }
                    lrun += ps;
                    bf16x8 pf[4];
#pragma unroll
                    for (int sf = 0; sf < 2; ++sf) {
                        u32x4 pw; pw.x = pk2(s0[8 * sf], s0[8 * sf + 1]); pw.y = pk2(s0[8 * sf + 2], s0[8 * sf + 3]); pw.z = pk2(s0[8 * sf + 4], s0[8 * sf + 5]); pw.w = pk2(s0[8 * sf + 6], s0[8 * sf + 7]); pf[sf] = __builtin_bit_cast(bf16x8, pw);
                        u32x4 pv; pv.x = pk2(s1[8 * sf], s1[8 * sf + 1]); pv.y = pk2(s1[8 * sf + 2], s1[8 * sf + 3]); pv.z = pk2(s1[8 * sf + 4], s1[8 * sf + 5]); pv.w = pk2(s1[8 * sf + 6], s1[8 * sf + 7]); pf[2 + sf] = __builtin_bit_cast(bf16x8, pv);
                    }
                    __builtin_amdgcn_sched_barrier(0); __builtin_amdgcn_s_setprio(1); __builtin_amdgcn_sched_barrier(0);
#pragma unroll
                    for (int q4 = 0; q4 < 4; ++q4)
#pragma unroll
                        for (int d = 0; d < NDB; ++d) o[d] = MFMA32(vf[q4][d], pf[q4], o[d]);
                    __builtin_amdgcn_sched_barrier(0); __builtin_amdgcn_s_setprio(0); __builtin_amdgcn_sched_barrier(0);
                } else {
                    f32x16 s0, s1;
                    if (PRIO) { s0 = negm; s1 = negm; } else {
#pragma unroll
                        for (int i = 0; i < 16; ++i) { s0[i] = 0.f; s1[i] = 0.f; } }
                    const LAS unsigned char* kb = lds + buf * KBUF + (64 * hf + r) * KS + h * 16;
                    if (PRIO) __builtin_amdgcn_s_setprio(1);
#pragma unroll
                    for (int ks = 0; ks < DQK / 16; ++ks) {
                        const bf16x8 a0 = *(const LAS bf16x8*)(kb + ks * 32), a1 = *(const LAS bf16x8*)(kb + 32 * KS + ks * 32);
                        s0 = MFMA32(a0, qf[ks], s0); s1 = MFMA32(a1, qf[ks], s1);
                    }
                    if (PRIO) __builtin_amdgcn_s_setprio(0);
                    if (CAUSAL && key0 + 63 > qlo) {
#pragma unroll
                        for (int i = 0; i < 16; ++i) { const int key = key0 + (i & 3) + 8 * (i >> 2) + 4 * h; if (key > qabs) s0[i] = -1e30f; if (key + 32 > qabs) s1[i] = -1e30f; }
                    }
                    if (!PRIO) {
#pragma unroll
                        for (int i = 0; i < 16; ++i) { s0[i] -= mrun; s1[i] -= mrun; } }
                    float rm = fmaxf(s0[0], s1[0]);
#pragma unroll
                    for (int i = 1; i < 16; ++i) rm = fmaxf(rm, fmaxf(s0[i], s1[i]));
                    rm = xhalf_max(rm);
                    if (first || __any(rm > THR)) {
                        const float dl = first ? rm : fmaxf(rm, 0.f), f = __builtin_amdgcn_exp2f(-dl);
                        mrun += dl; lrun *= f; first = false;
#pragma unroll
                        for (int i = 0; i < 16; ++i) { s0[i] -= dl; s1[i] -= dl; if (PRIO) negm[i] = -mrun; }
#pragma unroll
                        for (int d = 0; d < DV / 32; ++d)
#pragma unroll
                            for (int i = 0; i < 16; ++i) o[d][i] *= f;
                    }
                    const LAS unsigned char* vb = lds + VOFF + buf * VBUF + r * VS + h * 8 + 128 * hf;
                    float ps = 0.f;
#pragma unroll
                    for (int kb2 = 0; kb2 < 2; ++kb2) {
                        f32x16& sx = kb2 == 0 ? s0 : s1;
#pragma unroll
                        for (int i = 0; i < 16; ++i) { sx[i] = __builtin_amdgcn_exp2f(sx[i]); ps += sx[i]; }
                        if (PRIO) __builtin_amdgcn_s_setprio(1);
#pragma unroll
                        for (int sf = 0; sf < 2; ++sf) {
                            u32x4 pw; pw.x = pk2(sx[8 * sf], sx[8 * sf + 1]); pw.y = pk2(sx[8 * sf + 2], sx[8 * sf + 3]); pw.z = pk2(sx[8 * sf + 4], sx[8 * sf + 5]); pw.w = pk2(sx[8 * sf + 6], sx[8 * sf + 7]);
                            const bf16x8 pf = __builtin_bit_cast(bf16x8, pw);
#pragma unroll
                            for (int d = 0; d < DV / 32; ++d) {
                                const LAS unsigned char* vp = vb + d * 32 * VS + (32 * kb2 + 16 * sf) * 2;
                                const s16x4 lo = *(const LAS s16x4*)vp, hi = *(const LAS s16x4*)(vp + 16);
                                const bf16x8 a = (bf16x8){lo[0], lo[1], lo[2], lo[3], hi[0], hi[1], hi[2], hi[3]};
                                o[d] = MFMA32(a, pf, o[d]);
                                if (!PRIO) asm volatile("" ::: "memory");
                            }
                        }
                        if (PRIO) __builtin_amdgcn_s_setprio(0);
                    }
                    lrun += ps;
                }
            }
        }
        if (kt + 1 < nt) lstore(buf ^ 1);
        __syncthreads();
    }
    lrun = xhalf_sum(lrun);
    const float inv = 1.0f / lrun;
    bf16_t* orow = Ob + (size_t)(32 * w + r) * opitch;
#pragma unroll
    for (int d = 0; d < DV / 32; ++d)
#pragma unroll
        for (int g = 0; g < 4; ++g) { u32x2 wv; wv.x = pk2(o[d][4 * g] * inv, o[d][4 * g + 1] * inv); wv.y = pk2(o[d][4 * g + 2] * inv, o[d][4 * g + 3] * inv);
            *(u32x2*)(orow + 32 * d + 8 * g + 4 * h) = wv; }
}

#define MFMA16(a, b, c) __builtin_amdgcn_mfma_f32_16x16x32_bf16((a), (b), (c), 0, 0, 0)
DI void sgu_item(int g, int bc, int par, const bf16_t* SGW, const bf16_t* Vg, const float* VST, const float* lng, const float* lnb, const float* sgb, bf16_t* U, LAS unsigned char* lds) {
    constexpr int RS = 272;
    const int tid = threadIdx.x, lane = tid & 63, w = __builtin_amdgcn_readfirstlane(tid >> 6), row0 = bc * 128;
    LAS unsigned char* Wl = lds + par * (192 * RS); LAS unsigned char* Vl = Wl + 128 * RS;
    const int j = lane & 15, q = lane >> 4, t0 = 16 * w, nks = (t0 + 15) / 32 + 1, t = t0 + j;
    u32x4 wreg[4];
#pragma unroll
    for (int i = 0; i < 4; ++i) { const int c = tid + i * 512, rr = c >> 4, cc = c & 15; wreg[i] = *(const u32x4*)(SGW + (size_t)g * 16384 + rr * 128 + cc * 8); }
    const int s = tid & 127, dg = tid >> 7, row = row0 + s;
    f32x4 pst[8];
#pragma unroll
    for (int i = 0; i < 8; ++i) pst[i] = *(const f32x4*)(VST + (size_t)row * 32 + 4 * i);
    const u32x4 a = *(const u32x4*)(Vg + (size_t)row * 512 + g * 64 + dg * 16), b = *(const u32x4*)(Vg + (size_t)row * 512 + g * 64 + dg * 16 + 8);
    bf16_t* up = U + (size_t)(row0 + t) * 512 + g * 64 + 4 * q;
    u32x2 uu[4];
#pragma unroll
    for (int db = 0; db < 4; ++db) uu[db] = *(const u32x2*)(up + 16 * db);
    const float bias = sgb[g * 128 + t];
#pragma unroll
    for (int i = 0; i < 4; ++i) { const int c = tid + i * 512, rr = c >> 4, cc = c & 15; *(LAS u32x4*)(Wl + rr * RS + cc * 16) = wreg[i]; }
    {
        float s1 = 0.f, s2 = 0.f;
#pragma unroll
        for (int i = 0; i < 8; ++i) { s1 += pst[i][0] + pst[i][2]; s2 += pst[i][1] + pst[i][3]; }
        const float mu = s1 * (1.0f / 512.0f), var = s2 * (1.0f / 512.0f) - mu * mu, rstd = __builtin_amdgcn_rsqf(fmaxf(var, 0.f) + EPS);
        const unsigned wd[8] = {a.x, a.y, a.z, a.w, b.x, b.y, b.z, b.w};
#pragma unroll
        for (int i = 0; i < 8; ++i) {
            const int d = dg * 16 + 2 * i, c = g * 64 + d;
            const float v0 = (bflo(wd[i]) - mu) * rstd * lng[c] + lnb[c], v1 = (bfhi(wd[i]) - mu) * rstd * lng[c + 1] + lnb[c + 1];
            *(LAS bf16_t*)(Vl + d * RS + s * 2) = (bf16_t)f2bf(v0); *(LAS bf16_t*)(Vl + (d + 1) * RS + s * 2) = (bf16_t)f2bf(v1);
        }
    }
    __syncthreads();
    f32x4 acc[4];
#pragma unroll
    for (int db = 0; db < 4; ++db) acc[db] = (f32x4){0.f, 0.f, 0.f, 0.f};
    for (int ks = 0; ks < nks; ++ks) {
        const bf16x8 bw = *(const LAS bf16x8*)(Wl + (t0 + j) * RS + (32 * ks + 8 * q) * 2);
#pragma unroll
        for (int db = 0; db < 4; ++db) { const bf16x8 av = *(const LAS bf16x8*)(Vl + (16 * db + j) * RS + (32 * ks + 8 * q) * 2); acc[db] = MFMA16(av, bw, acc[db]); }
    }
#pragma unroll
    for (int db = 0; db < 4; ++db) {
        u32x2 wv; wv.x = pk2(bflo(uu[db].x) * (acc[db][0] + bias), bfhi(uu[db].x) * (acc[db][1] + bias)); wv.y = pk2(bflo(uu[db].y) * (acc[db][2] + bias), bfhi(uu[db].y) * (acc[db][3] + bias));
        *(u32x2*)(up + 16 * db) = wv;
    }
}

DI float wave_sum(float v) {
#pragma unroll
    for (int o = 1; o < 64; o <<= 1) v += __shfl_xor(v, o);
    return v;
}
DI bf16_t* dest_rows(int mode, int n0, int K, bf16_t* d0, bf16_t* d1) {
    if (mode == 1) { const int isu = n0 >= FF ? 1 : 0, c = n0 - isu * FF; return d0 + (size_t)((c >> 7) * 256 + isu * 128 + (c & 127)) * K; }
    if (mode == 2) {
        if (n0 < 1664) return d0 + (size_t)n0 * K;
        if (n0 < 1696) return d0 + (size_t)(2176 + n0 - 1664) * K;
        if (n0 < 2208) return d0 + (size_t)(1664 + n0 - 1696) * K;
        return d1 + (size_t)(n0 - 2208) * K;
    }
    return d0 + (size_t)n0 * K;
}
DI void transpose_mat(const float* W, int K, int N, const float* gk, int mode, bf16_t* d0, bf16_t* d1, LAS float* scr, int gw, int ngw, int lane, int nb0 = 0, int nb1 = -1) {
    if (nb1 < 0) nb1 = N / 32;
    const int nblk = nb1 - nb0, nitems = (K / 64) * nblk;
    for (int item = gw; item < nitems; item += ngw) {
        const int kb = item / nblk, nb = nb0 + item % nblk, k0 = 64 * kb, n0 = 32 * nb;
        float tv[32];
#pragma unroll
        for (int i = 0; i < 32; ++i) { const int kk = 2 * i + (lane >> 5); tv[i] = W[(size_t)(k0 + kk) * N + n0 + (lane & 31)]; }
#pragma unroll
        for (int i = 0; i < 32; ++i) { const int kk = 2 * i + (lane >> 5); float v = tv[i]; if (gk) v *= gk[k0 + kk]; scr[kk * 33 + (lane & 31)] = v; }
        asm volatile("s_waitcnt lgkmcnt(0)" ::: "memory");
        bf16_t* dst = dest_rows(mode, n0, K, d0, d1);
        const int c = lane & 7;
#pragma unroll
        for (int jj = 0; jj < 4; ++jj) { const int n = (lane >> 3) + 8 * jj; const LAS float* s = scr + (8 * c) * 33 + n;
            u32x4 o; o.x = pk2(s[0 * 33], s[1 * 33]); o.y = pk2(s[2 * 33], s[3 * 33]); o.z = pk2(s[4 * 33], s[5 * 33]); o.w = pk2(s[6 * 33], s[7 * 33]);
            *(u32x4*)(dst + (size_t)n * K + k0 + 8 * c) = o; }
        asm volatile("s_waitcnt lgkmcnt(0)" ::: "memory");
    }
}
DI void rms_row_to_bf16(const float* xrow, const float* gain, bf16_t* orow, int lane) {
    const f32x4* xr = (const f32x4*)xrow + lane;
    f32x4 v[4]; float s = 0.f;
#pragma unroll
    for (int jj = 0; jj < 4; ++jj) { v[jj] = xr[64 * jj]; s += (v[jj][0] * v[jj][0] + v[jj][1] * v[jj][1]) + (v[jj][2] * v[jj][2] + v[jj][3] * v[jj][3]); }
    const float rstd = 1.0f / sqrtf(wave_sum(s) * (1.0f / 1024.0f) + EPS);
    u32x2* o8 = (u32x2*)orow + lane;
#pragma unroll
    for (int jj = 0; jj < 4; ++jj) {
        f32x4 gg = (f32x4){1.f, 1.f, 1.f, 1.f}; if (gain) gg = ((const f32x4*)gain)[lane + 64 * jj];
        u32x2 wv; wv.x = pk2(v[jj][0] * rstd * gg[0], v[jj][1] * rstd * gg[1]); wv.y = pk2(v[jj][2] * rstd * gg[2], v[jj][3] * rstd * gg[3]); o8[64 * jj] = wv;
    }
}

#define RLX_AGENT __ATOMIC_RELAXED, __HIP_MEMORY_SCOPE_AGENT
#define XB_TMO      128
#define XB_XCNT(j)  (256  + 64 * (j))
#define XB_XSUB(j)  (1280 + 64 * (j))
#define XB_XGEN(j)  (2304 + 64 * (j))
#define XB_TOP      3328
#define XB_TOPGEN   3392
#define XCD_BAR_WORDS 3456
#define XB_SPIN_CAP (1u << 18)

__device__ __forceinline__ unsigned xb_ld(unsigned* p)              { return __hip_atomic_load(p, __ATOMIC_RELAXED, __HIP_MEMORY_SCOPE_AGENT); }
__device__ __forceinline__ unsigned xb_add(unsigned* p, unsigned v) { return __hip_atomic_fetch_add(p, v, __ATOMIC_RELAXED, __HIP_MEMORY_SCOPE_AGENT); }
__device__ __forceinline__ unsigned xb_xcc_id() { return (unsigned)__builtin_amdgcn_s_getreg((3 << 11) | 20) & 0xFu; }
#define XB_SPIN(cond, bar) do { unsigned _sp = 0; while (cond) { __builtin_amdgcn_s_sleep(1); \
    if ((++_sp & 255u) == 0u) { if (xb_ld(&(bar)[XB_TMO])) break; if (_sp > XB_SPIN_CAP) { atomicAdd(&(bar)[XB_TMO], 1u); break; } } } } while (0)

struct XcdBarrier {
    unsigned* bar; unsigned x;
    volatile LAS unsigned* st;
};

__device__ __forceinline__ XcdBarrier xcd_barrier_post(unsigned* bar, volatile LAS unsigned* st) {
    XcdBarrier b; b.bar = bar; b.x = xb_xcc_id(); b.st = st;
    if (threadIdx.x == 0) (void)xb_add(&bar[XB_XCNT(b.x)], 1u);
    return b;
}
__device__ __forceinline__ void xcd_barrier_complete(unsigned* bar, unsigned x, unsigned& nloc, unsigned& nx) {
    const unsigned G = gridDim.x * gridDim.y * gridDim.z;
    unsigned sum, cnt, mine, sp = 0u;
    for (;;) {
        sum = 0u; cnt = 0u; mine = 0u;
#pragma unroll
        for (unsigned j = 0; j < 16; ++j) { const unsigned c = xb_ld(&bar[XB_XCNT(j)]); sum += c; cnt += (c > 0u) ? 1u : 0u; mine = (j == x) ? c : mine; }
        if (sum == G) break;
        __builtin_amdgcn_s_sleep(1);
        if ((++sp & 255u) == 0u) { if (xb_ld(&bar[XB_TMO])) break; if (sp > XB_SPIN_CAP) { atomicAdd(&bar[XB_TMO], 1u); break; } }
    }
    nloc = mine > 0u ? mine : 1u; nx = cnt > 0u ? cnt : 1u;
}

__device__ __forceinline__ void xcd_barrier(const XcdBarrier& b) {
    asm volatile("s_waitcnt vmcnt(0)" ::: "memory");
    __syncthreads();
    if (threadIdx.x == 0) {
        unsigned* bar = b.bar;
        __builtin_amdgcn_s_waitcnt(0);
        unsigned nloc = b.st[0], nx = b.st[1];
        if (nloc == 0u) { xcd_barrier_complete(bar, b.x, nloc, nx); b.st[0] = nloc; b.st[1] = nx; }
        const unsigned old = xb_add(&bar[XB_XSUB(b.x)], 1u);
        const unsigned gen = old / nloc;
        if (old + 1u == (gen + 1u) * nloc) {
            __builtin_amdgcn_fence(__ATOMIC_RELEASE, "agent");
            asm volatile("s_waitcnt vmcnt(0)" ::: "memory");
            const unsigned og = xb_add(&bar[XB_TOP], 1u);
            const unsigned tg = og / nx;
            if (og + 1u == (tg + 1u) * nx) xb_add(&bar[XB_TOPGEN], 1u);
            else XB_SPIN(xb_ld(&bar[XB_TOPGEN]) == tg, bar);
            __builtin_amdgcn_fence(__ATOMIC_ACQUIRE, "agent");
            xb_add(&bar[XB_XGEN(b.x)], 1u);
            asm volatile("s_waitcnt vmcnt(0)" ::: "memory");
        } else {
            XB_SPIN(xb_ld(&bar[XB_XGEN(b.x)]) == gen, bar);
            __builtin_amdgcn_fence(__ATOMIC_ACQUIRE, "agent");
            asm volatile("s_waitcnt vmcnt(0)" ::: "memory");
        }
    }
    __syncthreads();
}

struct Args { const float* in[30]; float* out; unsigned char* ws; int ph_lo, ph_hi; };
constexpr int LDS_BYTES = 135168;
constexpr int NPH = 12;


#define wGU1 ((bf16_t*)(ws + W_GU1))
#define wDN1 ((bf16_t*)(ws + W_DN1))
#define wIN ((bf16_t*)(ws + W_IN))
#define wGT ((bf16_t*)(ws + W_GT))
#define wUQ ((bf16_t*)(ws + W_UQ))
#define wUKV ((bf16_t*)(ws + W_UKV))
#define wMKV ((bf16_t*)(ws + W_MKV))
#define wBA ((bf16_t*)(ws + W_BA))
#define wBB ((bf16_t*)(ws + W_BB))
#define wBC ((bf16_t*)(ws + W_BC))
#define wOUT ((bf16_t*)(ws + W_OUT))
#define wGU2 ((bf16_t*)(ws + W_GU2))
#define wDN2 ((bf16_t*)(ws + W_DN2))
#define wSG ((bf16_t*)(ws + W_SG))
#define SS1 ((float*)(ws + S_SS1))
#define SS2 ((float*)(ws + S_SS2))
#define VST ((float*)(ws + S_VST))
#define CQP ((float*)(ws + S_CQP))
#define CKVP ((float*)(ws + S_CKVP))
#define QMP ((float*)(ws + S_QMP))
#define KR ((float*)(ws + S_KR))
#define MEMN ((bf16_t*)(ws + S_MEMN))
#define MKV ((float*)(ws + S_MKV))
#define KM ((bf16_t*)(ws + S_KM))
#define VMT ((bf16_t*)(ws + S_VMT))
#define X1B ((bf16_t*)(ws + B_X1B))
#define MG ((bf16_t*)(ws + B_MG))
#define U ((bf16_t*)(ws + B_U))
#define QM ((bf16_t*)(ws + B_QM))
#define VG ((bf16_t*)(ws + B_VG))
#define KF ((bf16_t*)(ws + B_K))
#define CQ ((bf16_t*)(ws + B_CQ))
#define CKV ((bf16_t*)(ws + B_CKV))
#define QRAW ((bf16_t*)(ws + B_QRAW))
#define KN ((bf16_t*)(ws + B_KN))
#define VT ((bf16_t*)(ws + B_VT))
#define YB ((bf16_t*)(ws + B_YB))
#define YC ((bf16_t*)(ws + B_YC))
#define G0 ((bf16_t*)(ws + B_G0))
#define G1 ((bf16_t*)(ws + B_G1))
#define G2 ((bf16_t*)(ws + B_G2))
#define ACT ((bf16_t*)(ws + B_ACT))
#define XB ((bf16_t*)(ws + B_XB))
#define X2B ((bf16_t*)(ws + B_X2B))
#define MGO ((bf16_t*)out)
DI unsigned char* opaque_ptr(unsigned char* p) { asm volatile("" : "+s"(p)); return p; }
__global__ void __launch_bounds__(512, 2) fwd_mega(Args args) {
    extern __shared__ __attribute__((aligned(16))) unsigned char lds_raw[];
    LAS unsigned char* lds = (LAS unsigned char*)lds_raw;
    cg::grid_group grid = cg::this_grid();
    const int tid = threadIdx.x, lane = tid & 63, wave = __builtin_amdgcn_readfirstlane(tid >> 6);
    const int G = gridDim.x, bx = blockIdx.x;
    const float* x = args.in[0]; const float* mem = args.in[1]; const int* positions = (const int*)args.in[2];
    float* out = args.out;
    const int lo = args.ph_lo, hi = args.ph_hi;
#ifndef PH_MASK
#define PH_MASK 0xFFF
#endif
#define IN(k) (((PH_MASK >> (k)) & 1) && lo <= (k) && (k) < hi)
#ifndef DUP_MASK
#define DUP_MASK 0
#endif
#define DUP(k) for (int rep_ = 0; rep_ < 1 + ((DUP_MASK >> (k)) & 1); ++rep_)
#define SEAM(k) do { if (IN(k) && IN((k) + 1)) xcd_barrier(xbar); } while (0)
    if (args.ph_lo < 0) grid.sync();
    if (tid < 4) ((LAS unsigned*)(lds + 131072 + 1024))[tid] = 0u;
    __syncthreads();
    XcdBarrier xbar = xcd_barrier_post((unsigned*)(args.ws + S_BAR), (volatile LAS unsigned*)(lds + 131072 + 1024));
    const int gw = bx * 8 + wave, ngw = G * 8, gt = bx * 512 + tid, ngt = G * 512;

    if (IN(0)) DUP(0) { unsigned char* ws = opaque_ptr(args.ws);
        LAS float* scr = (LAS float*)(lds + wave * 16384);
        const bool defer = (G == 256);
        transpose_mat(args.in[4], 1024, 5632, args.in[3], 1, wGU1, nullptr, scr, gw, ngw, lane);
        transpose_mat(args.in[20], 1024, 1024, nullptr, 0, wMKV, nullptr, scr, gw, ngw, lane);
        if (!defer) {
            transpose_mat(args.in[5], 2816, 1024, nullptr, 0, wDN1, nullptr, scr, gw, ngw, lane);
            transpose_mat(args.in[7], 1024, 5280, args.in[6], 2, wIN, wGT, scr, gw, ngw, lane);
            transpose_mat(args.in[14], 384, 768, args.in[13], 0, wUQ, nullptr, scr, gw, ngw, lane);
            transpose_mat(args.in[16], 256, 1024, args.in[15], 0, wUKV, nullptr, scr, gw, ngw, lane);
            transpose_mat(args.in[23], 512, 1024, nullptr, 0, wBA, nullptr, scr, gw, ngw, lane);
            transpose_mat(args.in[24], 512, 1024, nullptr, 0, wBB, nullptr, scr, gw, ngw, lane);
            transpose_mat(args.in[25], 512, 1024, nullptr, 0, wBC, nullptr, scr, gw, ngw, lane);
            transpose_mat(args.in[26], 1024, 1024, nullptr, 0, wOUT, nullptr, scr, gw, ngw, lane);
            transpose_mat(args.in[28], 1024, 5632, args.in[27], 1, wGU2, nullptr, scr, gw, ngw, lane);
            transpose_mat(args.in[29], 2816, 1024, nullptr, 0, wDN2, nullptr, scr, gw, ngw, lane);
        }
        for (int i = gt; i < 96 * 1024 / 8; i += ngt) ((u32x4*)(wIN + (size_t)2208 * 1024))[i] = (u32x4){0u, 0u, 0u, 0u};
        for (int i = gt; i < T; i += ngt) { SS1[i] = 0.f; SS2[i] = 0.f; CQP[i] = 0.f; CKVP[i] = 0.f; }
        for (int m = 2 * gw; m < T; m += 2 * ngw) {
            const f32x4* x0 = (const f32x4*)(x + (size_t)m * DM) + lane; const f32x4* x1 = x0 + DM / 4;
            f32x4 v0[4], v1[4]; float s0 = 0.f, s1 = 0.f;
#pragma unroll
            for (int jj = 0; jj < 4; ++jj) { v0[jj] = x0[64 * jj]; v1[jj] = x1[64 * jj]; }
#pragma unroll
            for (int jj = 0; jj < 4; ++jj) { s0 += (v0[jj][0] * v0[jj][0] + v0[jj][1] * v0[jj][1]) + (v0[jj][2] * v0[jj][2] + v0[jj][3] * v0[jj][3]);
                                             s1 += (v1[jj][0] * v1[jj][0] + v1[jj][1] * v1[jj][1]) + (v1[jj][2] * v1[jj][2] + v1[jj][3] * v1[jj][3]); }
            const float q0_ = sqrtf(wave_sum(s0) * (1.0f / 1024.0f) + EPS), q1_ = sqrtf(wave_sum(s1) * (1.0f / 1024.0f) + EPS), r0 = 1.0f / q0_, r1 = 1.0f / q1_;
            if (lane == 0) { ((float*)(ws + S_R0))[m] = q0_; ((float*)(ws + S_R0))[m + 1] = q1_; }
            u32x2* o0 = (u32x2*)(XB + (size_t)m * DM) + lane; u32x2* o1 = o0 + DM / 4;
#pragma unroll
            for (int jj = 0; jj < 4; ++jj) { u32x2 w0, w1; w0.x = pk2(v0[jj][0] * r0, v0[jj][1] * r0); w0.y = pk2(v0[jj][2] * r0, v0[jj][3] * r0); w1.x = pk2(v1[jj][0] * r1, v1[jj][1] * r1); w1.y = pk2(v1[jj][2] * r1, v1[jj][3] * r1);
                o0[64 * jj] = w0; o1[64 * jj] = w1; }
        }
        for (int m = gw; m < 512; m += ngw) rms_row_to_bf16(mem + (size_t)m * DM, args.in[19], MEMN + (size_t)m * DM, lane);
        { const float* sgw = args.in[11];
          for (int i = gt; i < 8 * 128 * 128 / 2; i += ngt) { const int e = 2 * i, s = e & 127, t = (e >> 7) & 127; const float a = s <= t ? sgw[e] : 0.f, b = (s + 1) <= t ? sgw[e + 1] : 0.f; ((unsigned*)wSG)[i] = pk2(a, b); } }
    }
    SEAM(0);
#ifdef EXTRA_SYNCS
    for (int i_ = 0; i_ < EXTRA_SYNCS; ++i_) xcd_barrier(xbar);
#endif
    if (IN(1)) DUP(1) { unsigned char* ws = opaque_ptr(args.ws);
        { pg8::Gemm g{XB, wGU1, T, 5632, 1024}; pg8::StaticOrder S; S.init(T, 5632, G, bx); EpiSwiglu<0> E{ACT, nullptr};
          pg8::gemm_phase<EpiSwiglu<0>, pg8::StaticOrder, true, true>(lds, g, S, E); }
        { pg8::Gemm g{MEMN, wMKV, 512, 1024, 1024}; pg8::StaticOrder S; S.init(512, 1024, G, (bx + 128) % G); EpiF32 E{MKV, 1024};
          pg8::gemm_phase<EpiF32, pg8::StaticOrder, true, true>(lds, g, S, E); }
        if (G == 256 && bx >= 128) {
            LAS float* scr = (LAS float*)(lds + wave * 16384); const int gw2 = (bx - 128) * 8 + wave, ngw2 = 128 * 8;
            transpose_mat(args.in[5], 2816, 1024, nullptr, 0, wDN1, nullptr, scr, gw2, ngw2, lane);
            transpose_mat(args.in[7], 1024, 5280, args.in[6], 2, wIN, wGT, scr, gw2, ngw2, lane, 0, 69);
            transpose_mat(args.in[14], 384, 768, args.in[13], 0, wUQ, nullptr, scr, gw2, ngw2, lane);
            transpose_mat(args.in[16], 256, 1024, args.in[15], 0, wUKV, nullptr, scr, gw2, ngw2, lane);
        }
    }
    SEAM(1);
    if (IN(2)) DUP(2) { unsigned char* ws = opaque_ptr(args.ws); const bool dry = rep_ < ((DUP_MASK >> 2) & 1);
        pg8::Gemm g{ACT, wDN1, T, 1024, FF}; pg8::StaticOrder S; S.init(T, 1024, G, bx); EpiResid<true, true, false> E{(const float*)(ws + S_R0), XB, nullptr, X1B, dry ? (float*)(ws + S_DUMMY) : SS1, 0.5f};
        pg8::gemm_phase<EpiResid<true, true, false>, pg8::StaticOrder, true, true>(lds, g, S, E);
    }
    SEAM(2);
    if (IN(3)) DUP(3) { unsigned char* ws = opaque_ptr(args.ws); const bool dry = rep_ < ((DUP_MASK >> 3) & 1);
        pg8::Gemm g{X1B, wIN, T, NWIN, 1024}; pg8::StaticOrder S; S.init(T, NWIN, G, bx); EpiWin E{SS1, U, VG, CQ, CKV, QM, KR, VST, dry ? (float*)(ws + S_DUMMY) : CQP, dry ? (float*)(ws + S_DUMMY) : CKVP, QMP};
        pg8::gemm_phase<EpiWin, pg8::StaticOrder, true, true>(lds, g, S, E);
        if (G == 256 && bx >= 64) {
            LAS float* scr = (LAS float*)(lds + wave * 16384); const int gw2 = (bx - 64) * 8 + wave, ngw2 = 192 * 8;
            transpose_mat(args.in[7], 1024, 5280, args.in[6], 2, wIN, wGT, scr, gw2, ngw2, lane, 69, 165);
            transpose_mat(args.in[23], 512, 1024, nullptr, 0, wBA, nullptr, scr, gw2, ngw2, lane);
            transpose_mat(args.in[24], 512, 1024, nullptr, 0, wBB, nullptr, scr, gw2, ngw2, lane);
            transpose_mat(args.in[25], 512, 1024, nullptr, 0, wBC, nullptr, scr, gw2, ngw2, lane);
            transpose_mat(args.in[26], 1024, 1024, nullptr, 0, wOUT, nullptr, scr, gw2, ngw2, lane);
            transpose_mat(args.in[28], 1024, 5632, args.in[27], 1, wGU2, nullptr, scr, gw2, ngw2, lane);
            transpose_mat(args.in[29], 2816, 1024, nullptr, 0, wDN2, nullptr, scr, gw2, ngw2, lane);
        }
    }
    SEAM(3);
    if (IN(4)) DUP(4) { unsigned char* ws = opaque_ptr(args.ws); const bool dry = rep_ < ((DUP_MASK >> 4) & 1);
#ifndef NO_UQ
        { int kk = 384; asm volatile("" : "+s"(kk)); pg8::Gemm g{CQ, wUQ, T, 768, kk}; pg8::StaticOrder S; S.init(T, 768, G, bx); EpiUq E{CQP, QRAW};
          pg8::gemm_phase<EpiUq, pg8::StaticOrder, true, true>(lds, g, S, E); }
#endif
#ifndef NO_UKV
        { int kk = 256; asm volatile("" : "+s"(kk)); pg8::Gemm g{CKV, wUKV, T, 1024, kk}; pg8::StaticOrder S; S.init(T, 1024, G, bx); EpiUkv E{CKVP, KN, VT};
          pg8::gemm_phase<EpiUkv, pg8::StaticOrder, true, true>(lds, g, S, E); }
#endif
        __syncthreads();
#ifndef NO_SGU
        if (!dry) { int par = 0; for (int it = bx; it < 1024; it += G, par ^= 1) sgu_item(it >> 7, it & 127, par, wSG, VG, VST, args.in[9], args.in[10], args.in[12], U, lds); __syncthreads(); }
#endif
    }
    SEAM(4);
    if (IN(5)) { unsigned char* ws = opaque_ptr(args.ws);
        {
            constexpr int NB = 4;
            const float* qn = args.in[17]; const float* kn = args.in[18];
            const int m = lane & 15, grp = lane >> 4; const bool act = m < 12, isrope = m >= 8 && m < 12, isx1 = m < 10; const int mm = act ? m : 0, i0 = 8 * (m & 1);
            float gq[8], gk[8], inv[8];
#pragma unroll
            for (int e = 0; e < 8; ++e) { gq[e] = qn[8 * mm + e] * QSCALE_MLA; gk[e] = kn[8 * mm + e]; inv[e] = ROPE_INV[i0 + e]; }
#pragma unroll 1
            for (int it0 = gw * NB; it0 < T * 2; it0 += ngw * NB) {
                u32x4 qa[NB], ka[NB]; f32x4 kb0[NB], kb1[NB]; float pos[NB];
#pragma unroll
                for (int u = 0; u < NB; ++u) {
                    const int task = (it0 + u) * 4 + grp, tok = task >> 3, hd = task & 7;
                    pos[u] = (float)positions[tok];
                    qa[u] = (u32x4){0u, 0u, 0u, 0u}; ka[u] = (u32x4){0u, 0u, 0u, 0u}; kb0[u] = (f32x4){0.f, 0.f, 0.f, 0.f}; kb1[u] = (f32x4){0.f, 0.f, 0.f, 0.f};
                    if (m < 8) ka[u] = *(const u32x4*)(KN + (size_t)tok * 512 + hd * 64 + 8 * m);
                    if (isrope) { kb0[u] = *(const f32x4*)(KR + (size_t)tok * 32 + 8 * (m - 8)); kb1[u] = *(const f32x4*)(KR + (size_t)tok * 32 + 8 * (m - 8) + 4); }
                }
#pragma unroll
                for (int u = 0; u < NB; ++u) {
                    const int task = (it0 + u) * 4 + grp, tok = task >> 3, hd = task & 7;
                    float cs[8], sn[8];
#pragma unroll
                    for (int e = 0; e < 8; ++e) { const float ang = pos[u] * inv[e]; const double rev = (double)ang * 0.15915494309189535; const float f = (float)(rev - floor(rev));
                        cs[e] = __builtin_amdgcn_cosf(f); sn[e] = __builtin_amdgcn_sinf(f); }
                    float v[8];
                    {
                        const u32x4 a = ka[u];
                        if (m < 8) { v[0] = bflo(a.x); v[1] = bfhi(a.x); v[2] = bflo(a.y); v[3] = bfhi(a.y); v[4] = bflo(a.z); v[5] = bfhi(a.z); v[6] = bflo(a.w); v[7] = bfhi(a.w); }
                        else { v[0] = kb0[u][0]; v[1] = kb0[u][1]; v[2] = kb0[u][2]; v[3] = kb0[u][3]; v[4] = kb1[u][0]; v[5] = kb1[u][1]; v[6] = kb1[u][2]; v[7] = kb1[u][3]; }
                        float ss = 0.f;
#pragma unroll
                        for (int e = 0; e < 8; ++e) ss += v[e] * v[e];
                        ss += __shfl_xor(ss, 1); ss += __shfl_xor(ss, 2); ss += __shfl_xor(ss, 4); ss += __shfl_xor(ss, 8);
                        const float rk = __builtin_amdgcn_rsqf(ss * (1.0f / 96.0f) + EPS);
#pragma unroll
                        for (int e = 0; e < 8; ++e) v[e] = v[e] * rk * gk[e];
#pragma unroll
                        for (int e = 0; e < 8; ++e) { const float o = __shfl_xor(v[e], 2); if (isrope) v[e] = isx1 ? v[e] * cs[e] - o * sn[e] : v[e] * cs[e] + o * sn[e]; }
                        if (act) { u32x4 w; w.x = pk2(v[0], v[1]); w.y = pk2(v[2], v[3]); w.z = pk2(v[4], v[5]); w.w = pk2(v[6], v[7]); *(u32x4*)(KF + (size_t)tok * 768 + hd * 96 + 8 * m) = w; }
                    }
                }
            }
        }
        {
            const float* mkn = args.in[22];
            for (int idx = gw; idx < 512 * 4; idx += ngw) {
                const int row = idx >> 2, hd = idx & 3;
                const float a = MKV[(size_t)row * 1024 + hd * 128 + 2 * lane], b = MKV[(size_t)row * 1024 + hd * 128 + 2 * lane + 1];
                const float rk = __builtin_amdgcn_rsqf(wave_sum(a * a + b * b) * (1.0f / 128.0f) + EPS);
                ((unsigned*)(KM + (size_t)row * 512 + hd * 128))[lane] = pk2(a * rk * mkn[2 * lane], b * rk * mkn[2 * lane + 1]);
            }
            for (int i = gt; i < 2 * 4 * 128 * 256; i += ngt) { const int m = i & 255, d = (i >> 8) & 127, hd = (i >> 15) & 3, b = i >> 17;
                VMT[i] = (bf16_t)f2bf(MKV[(size_t)(b * 256 + m) * 1024 + 512 + hd * 128 + d]); }
        }
    }
    SEAM(5);
    if (IN(6)) DUP(6) { unsigned char* ws = opaque_ptr(args.ws);
        const int vcu = (G % 8 == 0) ? (bx % 8) * (G / 8) + bx / 8 : bx;
        float kbound;
        { const float* kng = args.in[18]; float gmx = fabsf(kng[lane]); if (lane < 32) gmx = fmaxf(gmx, fabsf(kng[64 + lane]));
#pragma unroll
          for (int o_ = 1; o_ < 64; o_ <<= 1) gmx = fmaxf(gmx, __shfl_xor(gmx, o_));
          kbound = gmx * 9.797958971f * 1.01f; }
#ifndef NO_MLA
        for (int p = vcu; p < 256; p += G) {
            const int bh = p >> 4, s = p & 15, b = bh >> 3, hd = bh & 7;
#pragma unroll 1
            for (int e = 0; e < 2; ++e) {
                const int qb = e == 0 ? 31 - s : s, q0 = qb * 256;
                attn_unit<96, 64, true, 128, true>(QRAW + ((size_t)(b * SEQ + q0)) * 768 + hd * 96, 768, KF + (size_t)b * SEQ * 768 + hd * 96, 768, VT + (size_t)(b * 8 + hd) * 64 * SEQ, SEQ,
                                        YB + ((size_t)(b * SEQ + q0)) * 512 + hd * 64, 512, q0, (q0 + 256) / 128, lds, kbound, args.in[17], positions + b * SEQ + q0, QSCALE_MLA);
            }
        }
#endif
#ifndef NO_MEMATT
        for (int p = bx; p < 256; p += G) {
            const int qb = p & 31, hd = (p >> 5) & 3, b = p >> 7, q0 = qb * 256;
            attn_unit<128, 128, false, 64, false>(QM + ((size_t)(b * SEQ + q0)) * 512 + hd * 128, 512, KM + (size_t)b * 256 * 512 + hd * 128, 512, VMT + (size_t)(b * 4 + hd) * 128 * 256, 256,
                                       YC + ((size_t)(b * SEQ + q0)) * 512 + hd * 128, 512, q0, 4, lds, 0.f, args.in[21], nullptr, QSCALE_MEM);
        }
#endif
    }
    SEAM(6);
    if (IN(7)) DUP(7) { unsigned char* ws = opaque_ptr(args.ws);
        pg8::Gemm g{X1B, wGT, T, NGATE, 1024}; GateOrder S; S.base.init(T, 1024, G, bx); EpiGate E{SS1, args.in[8], G0};
        pg8::gemm_phase<EpiGate, GateOrder, true, true>(lds, g, S, E);
    }
    if (IN(8)) DUP(8) { unsigned char* ws = opaque_ptr(args.ws);
        static_assert(B_YB - B_U == 16 * MiB && B_YC - B_YB == 16 * MiB && W_BB - W_BA == MiB && W_BC - W_BB == MiB, "branch operands contiguous");
        int kk = 512; asm volatile("" : "+s"(kk));
        pg8::Gemm g{U, wBA, 3 * T, 3072, kk}; BranchOrder S; S.base.init(T, 1024, G, bx); EpiBranch E{G0, MGO};
        pg8::gemm_phase<EpiBranch, BranchOrder, true, true>(lds, g, S, E);
    }
    SEAM(8);
    if (IN(9)) DUP(9) { unsigned char* ws = opaque_ptr(args.ws); const bool dry = rep_ < ((DUP_MASK >> 9) & 1);
        pg8::Gemm g{MGO, wOUT, T, 1024, 1024}; pg8::StaticOrder S; S.init(T, 1024, G, bx); EpiResid<true, true, false> E{nullptr, X1B, nullptr, X2B, dry ? (float*)(ws + S_DUMMY) : SS2, 1.0f};
        pg8::gemm_phase<EpiResid<true, true, false>, pg8::StaticOrder, true, true>(lds, g, S, E);
    }
    SEAM(9);
    if (IN(10)) DUP(10) { unsigned char* ws = opaque_ptr(args.ws);
        pg8::Gemm g{X2B, wGU2, T, 5632, 1024}; pg8::StaticOrder S; S.init(T, 5632, G, bx); EpiSwiglu<16> E{ACT, SS2};
        pg8::gemm_phase<EpiSwiglu<16>, pg8::StaticOrder, true, true>(lds, g, S, E);
    }
    SEAM(10);
    if (IN(11)) DUP(11) { unsigned char* ws = opaque_ptr(args.ws); const bool dry = rep_ < ((DUP_MASK >> 11) & 1);
        pg8::Gemm g{ACT, wDN2, T, 1024, FF}; pg8::StaticOrder S; S.init(T, 1024, G, bx); EpiResid<false, true, true> E{nullptr, X2B, out, nullptr, nullptr, 0.5f};
        pg8::gemm_phase<EpiResid<false, true, true>, pg8::StaticOrder, true, true>(lds, g, S, E);
    }
#undef IN
#undef SEAM
}

#ifndef N_LAUNCH_SPLIT
#define N_LAUNCH_SPLIT 0
#endif
extern "C" void kernel_launch(void* const* d_in, const int* in_sizes, int n_in, void* d_out, int out_size, void* d_ws, size_t ws_size, hipStream_t stream) {
    static int grid = 0;
    if (grid == 0) {
        if (n_in != 30 || out_size != T * DM || ws_size < WS_NEED) { fprintf(stderr, "kernel_launch: unexpected shapes (n_in %d out %d ws %zu)\n", n_in, out_size, ws_size); grid = -1; return; }
        int dev = 0, cus = 0, per_cu = 0;
        hipGetDevice(&dev); hipDeviceGetAttribute(&cus, hipDeviceAttributeMultiprocessorCount, dev);
        if (hipFuncSetAttribute((const void*)fwd_mega, hipFuncAttributeMaxDynamicSharedMemorySize, LDS_BYTES) != hipSuccess) { fprintf(stderr, "kernel_launch: hipFuncSetAttribute failed\n"); grid = -1; return; }
        if (hipOccupancyMaxActiveBlocksPerMultiprocessor(&per_cu, (const void*)fwd_mega, 512, LDS_BYTES) != hipSuccess || per_cu < 1) { fprintf(stderr, "kernel_launch: occupancy query says %d\n", per_cu); per_cu = 1; }
        (void)hipGetLastError();
        grid = cus * 1;
        if (grid > cus * per_cu) grid = cus * per_cu;
    }
    if (grid < 0) return;
    if (hipMemsetAsync((char*)d_ws + S_BAR, 0, XCD_BAR_WORDS * 4, stream) != hipSuccess) { fprintf(stderr, "kernel_launch: hipMemsetAsync of the barrier words failed\n"); return; }
    Args a{};
    for (int i = 0; i < 30; ++i) a.in[i] = (const float*)d_in[i];
    a.out = (float*)d_out; a.ws = (unsigned char*)d_ws;
#if N_LAUNCH_SPLIT
    for (int p = 0; p < NPH; ++p) { a.ph_lo = p; a.ph_hi = p + 1; void* kargs[] = {&a}; hipError_t e = hipLaunchCooperativeKernel((const void*)fwd_mega, dim3(grid), dim3(512), kargs, LDS_BYTES, stream);
        if (e != hipSuccess) { fprintf(stderr, "launch %d failed: %s\n", p, hipGetErrorString(e)); break; } }
#else
    a.ph_lo = 0; a.ph_hi = NPH; void* kargs[] = {&a};
    hipError_t e = hipLaunchCooperativeKernel((const void*)fwd_mega, dim3(grid), dim3(512), kargs, LDS_BYTES, stream);
    if (e != hipSuccess) fprintf(stderr, "cooperative launch failed: %s (grid %d)\n", hipGetErrorString(e), grid);
#endif
}
```

```cpp
#include <hip/hip_runtime.h>
#include <hip/hip_cooperative_groups.h>
#include <cstdio>
#include <cstdint>
namespace cg = cooperative_groups;
namespace pg8 {
#define PG8_LAS __attribute__((address_space(3)))
typedef unsigned short bf16_t;
typedef short bf16x8 __attribute__((ext_vector_type(8)));
typedef float f32x4 __attribute__((ext_vector_type(4)));
typedef unsigned u32x4 __attribute__((ext_vector_type(4)));
constexpr int BM = 256, BK = 64, HALF = 128, HTB = HALF * BK * 2  , STAGE_BYTES = 8 * HTB, NXCD = 8, WGM = 8;

__host__ __device__ __forceinline__ int lds_byte(int r, int c) { const int st = (r >> 4) * 2 + (c >> 5), rr = r & 15, cc = c & 31, ob = rr * 64 + cc * 2; return st * 1024 + (ob ^ (((ob >> 9) & 1) << 5)); }
__host__ __device__ __forceinline__ void stage_rc(int b, int& R, int& C) { const int st = b / 1024, sb = b % 1024, swz = sb ^ (((sb >> 9) & 1) << 5); R = (st >> 1) * 16 + swz / 64; C = (st & 1) * 32 + (swz % 64) / 2; }
__host__ __device__ __forceinline__ int perm32(int rho) { const int n = rho >> 4, i = rho & 15; return 8 * (i >> 2) + 4 * n + (i & 3); }

struct Unit { int pm, pn; };
struct Gemm { const bf16_t* A; const bf16_t* Bt; int M, N, K; };

struct StaticOrder {
    int nM, nN, nwg, G, c;
    __host__ __device__ void init(int M, int N, int G_, int c_) { nM = M / BM; nN = N / BM; nwg = nM * nN; G = G_; c = c_; }
    __host__ __device__ bool next(int i, Unit& u) const {
        const long L = (long)i * G + c; if (L >= nwg) return false;
        int wgid = (int)L; { const int q = nwg / NXCD, r = nwg % NXCD, xcd = wgid % NXCD, off = wgid / NXCD; wgid = (xcd < r ? xcd * (q + 1) : r * (q + 1) + (xcd - r) * q) + off; }
        const int nig = WGM * nN, gid = wgid / nig, fm = gid * WGM, gsz = (nM - fm) < WGM ? (nM - fm) : WGM;
        u.pm = fm + ((wgid % nig) % gsz); u.pn = (wgid % nig) / gsz; return true;
    }
    __device__ __forceinline__ void a_ready(const Unit&) const {}
    __device__ __forceinline__ void done(const Unit&) const {}
};
__device__ __forceinline__ unsigned cvt_pk_bf16(float lo, float hi) { unsigned r; asm volatile("v_cvt_pk_bf16_f32 %0, %1, %2" : "=v"(r) : "v"(lo), "v"(hi)); return r; }
typedef float f32x2 __attribute__((ext_vector_type(2)));
__device__ __forceinline__ f32x2 gelu_pk(f32x2 v) {
    const f32x2 av = __builtin_elementwise_abs(v), d = av * 0.2316418882f + 1.0f;
    f32x2 t; t.x = __builtin_amdgcn_rcpf(d.x); t.y = __builtin_amdgcn_rcpf(d.y);
    f32x2 q = t * 0.5307027145f + (-0.7265760135f); q = q * t + 0.7107068705f; q = q * t + (-0.142248368f); q = q * t + 0.127414796f; q = q * t;
    const f32x2 s = (v * v) * (-0.72134752044f);
    f32x2 e; e.x = __builtin_amdgcn_exp2f(s.x); e.y = __builtin_amdgcn_exp2f(s.y);
    const f32x2 m = v * (q * e), r = v - m;
    f32x2 o; o.x = v.x < 0.f ? m.x : r.x; o.y = v.y < 0.f ? m.y : r.y; return o;
}
template <class Epi, class Sched, bool ALIGN_EPI = false, bool SP2 = false>
__device__ __forceinline__ void gemm_phase(PG8_LAS unsigned char* lds, const Gemm g, const Sched& S, const Epi& E) {
    const int tid = threadIdx.x, wid = __builtin_amdgcn_readfirstlane(tid >> 6), lane = tid & 63, wr = wid >> 2, wc = wid & 3, fr = lane & 15, fq = lane >> 4;
    const int K = g.K, nt = K / BK;
    unsigned voffA[2], voffB[2];
#pragma unroll
    for (int i = 0; i < 2; ++i) { int R, C; stage_rc(tid * 16 + i * 8192, R, C); const int Rb = Epi::PERM ? ((R & ~31) + perm32(R & 31)) : R;
        voffA[i] = (unsigned)(R * K + C) * 2u; voffB[i] = (unsigned)(Rb * K + C) * 2u; }
    const size_t kstep = (size_t)(BK * 2);
    const size_t hstep = (size_t)HALF * K * 2;
    const size_t tstep = 2 * hstep;
    const unsigned ldsw = (unsigned)wid * 1024u;
    const int aoff = lds_byte(wr * 64 + fr, fq * 8), boff = lds_byte(wc * 32 + fr, fq * 8);
#define PG8_SA(b, h) (((b) * 2 + (h)) * HTB)
#define PG8_SB(b, h) ((4 + (b) * 2 + (h)) * HTB)
#define PG8_STAGE(bufoff, gbase, voff) do { _Pragma("unroll") for (int _i = 0; _i < 2; ++_i) \
        __builtin_amdgcn_global_load_lds((const unsigned*)((const char*)(gbase) + (voff)[_i]), (PG8_LAS unsigned*)(lds + (bufoff) + ldsw + _i * 8192), 16, 0, 0); } while (0)
#define PG8_LDA(dst, b, h) do { _Pragma("unroll") for (int m = 0; m < 4; ++m) _Pragma("unroll") for (int k = 0; k < 2; ++k) dst[m][k] = *(const PG8_LAS bf16x8*)(lds + PG8_SA(b, h) + aoff + m * 2048 + k * 1024); } while (0)
#define PG8_LDB(dst, b, h) do { _Pragma("unroll") for (int n = 0; n < 2; ++n) _Pragma("unroll") for (int k = 0; k < 2; ++k) dst[n][k] = *(const PG8_LAS bf16x8*)(lds + PG8_SB(b, h) + boff + n * 2048 + k * 1024); } while (0)
#define PG8_MMA(ai, bj, At, Bt) do { __builtin_amdgcn_s_setprio(1); _Pragma("unroll") for (int m = 0; m < 4; ++m) _Pragma("unroll") for (int n = 0; n < 2; ++n) _Pragma("unroll") for (int k = 0; k < 2; ++k) \
        acc[ai][bj][m][n] = __builtin_amdgcn_mfma_f32_16x16x32_bf16(Bt[n][k], At[m][k], acc[ai][bj][m][n], 0, 0, 0); __builtin_amdgcn_s_setprio(0); } while (0)
#define PG8_WAIT_V(n) asm volatile("s_waitcnt vmcnt(" #n ")" ::: "memory")
#define PG8_WAIT_L(n) asm volatile("s_waitcnt lgkmcnt(" #n ")" ::: "memory")
#define PG8_BAR __builtin_amdgcn_s_barrier()
#define PG8_SCHED __builtin_amdgcn_sched_barrier(0)
    Unit cur, nxt; int ui = 0;
    if (!S.next(0, cur)) return;
    f32x4 acc[2][2][4][2];
#pragma unroll
    for (int a = 0; a < 2; ++a)
#pragma unroll
        for (int b = 0; b < 2; ++b)
#pragma unroll
            for (int m = 0; m < 4; ++m)
#pragma unroll
                for (int n = 0; n < 2; ++n) acc[a][b][m][n] = (f32x4){0.f, 0.f, 0.f, 0.f};
    bf16x8 At[4][2], B0[2][2], B1[2][2];
    const char* cA = (const char*)g.A + (size_t)cur.pm * tstep; const char* cB = (const char*)g.Bt + (size_t)cur.pn * tstep;
    S.a_ready(cur);
    if constexpr (SP2) {
        PG8_STAGE(PG8_SB(0, 0), cB, voffB); PG8_STAGE(PG8_SB(0, 1), cB + hstep, voffB); PG8_STAGE(PG8_SA(0, 0), cA, voffA); PG8_STAGE(PG8_SA(0, 1), cA + hstep, voffA);
        if (wr == 1) PG8_BAR;
        PG8_WAIT_V(2); PG8_BAR;
        PG8_STAGE(PG8_SB(1, 0), cB + kstep, voffB); PG8_STAGE(PG8_SA(1, 0), cA + kstep, voffA); PG8_STAGE(PG8_SB(1, 1), cB + hstep + kstep, voffB);
        PG8_WAIT_V(6); PG8_BAR;
    } else {
        PG8_STAGE(PG8_SB(0, 0), cB, voffB); PG8_STAGE(PG8_SA(0, 0), cA, voffA); PG8_STAGE(PG8_SB(0, 1), cB + hstep, voffB); PG8_STAGE(PG8_SA(0, 1), cA + hstep, voffA);
        if (wr == 1) PG8_BAR;
        PG8_WAIT_V(4); PG8_BAR;
        PG8_STAGE(PG8_SB(1, 0), cB + kstep, voffB); PG8_STAGE(PG8_SA(1, 0), cA + kstep, voffA); PG8_STAGE(PG8_SB(1, 1), cB + hstep + kstep, voffB);
        PG8_WAIT_V(6); PG8_BAR;
    }
    for (;;) {
        const bool has_next = S.next(ui + 1, nxt);
        const char* nA = has_next ? (const char*)g.A + (size_t)nxt.pm * tstep : cA; const char* nB = has_next ? (const char*)g.Bt + (size_t)nxt.pn * tstep : cB;
        for (int t = 0; t < nt; t += 2) {
            const bool last = (t == nt - 2);
            const char* a1 = cA + (size_t)(t + 1) * kstep;
            const char* a2 = last ? nA : cA + (size_t)(t + 2) * kstep; const char* b2 = last ? nB : cB + (size_t)(t + 2) * kstep;
            const char* a3 = a2 + kstep; const char* b3 = b2 + kstep;
            if (last && has_next) S.a_ready(nxt);
            if constexpr (SP2) {
            PG8_LDB(B0, 0, 0); PG8_LDB(B1, 0, 1); PG8_SCHED; PG8_LDA(At, 0, 0); PG8_STAGE(PG8_SA(1, 1), a1 + hstep, voffA);
            PG8_WAIT_V(8); PG8_WAIT_L(0); PG8_BAR; PG8_MMA(0, 0, At, B0); PG8_MMA(0, 1, At, B1); PG8_BAR; PG8_SCHED;
            PG8_LDA(At, 0, 1); PG8_STAGE(PG8_SB(0, 0), b2, voffB); PG8_STAGE(PG8_SB(0, 1), b2 + hstep, voffB); PG8_STAGE(PG8_SA(0, 0), a2, voffA);
            PG8_WAIT_V(8); PG8_WAIT_L(0); PG8_BAR; PG8_MMA(1, 0, At, B0); PG8_MMA(1, 1, At, B1); PG8_BAR; PG8_SCHED;
            PG8_LDB(B0, 1, 0); PG8_LDB(B1, 1, 1); PG8_SCHED; PG8_LDA(At, 1, 0); PG8_STAGE(PG8_SA(0, 1), a2 + hstep, voffA);
            PG8_WAIT_V(8); PG8_WAIT_L(0); PG8_BAR; PG8_MMA(0, 0, At, B0); PG8_MMA(0, 1, At, B1); PG8_BAR; PG8_SCHED;
            PG8_LDA(At, 1, 1); PG8_STAGE(PG8_SB(1, 0), b3, voffB); PG8_STAGE(PG8_SB(1, 1), b3 + hstep, voffB); PG8_STAGE(PG8_SA(1, 0), a3, voffA);
            PG8_WAIT_V(8); PG8_WAIT_L(0); PG8_BAR; PG8_MMA(1, 0, At, B0); PG8_MMA(1, 1, At, B1); PG8_BAR; PG8_SCHED;
            } else {
            PG8_LDB(B0, 0, 0); PG8_SCHED; PG8_LDA(At, 0, 0); PG8_STAGE(PG8_SA(1, 1), a1 + hstep, voffA);
            PG8_WAIT_L(8); PG8_BAR; PG8_WAIT_L(0); PG8_MMA(0, 0, At, B0); PG8_BAR; PG8_SCHED;
            PG8_LDB(B1, 0, 1); PG8_STAGE(PG8_SB(0, 0), b2, voffB);
            PG8_BAR; PG8_WAIT_L(0); PG8_MMA(0, 1, At, B1); PG8_BAR;
            PG8_LDA(At, 0, 1); PG8_STAGE(PG8_SA(0, 0), a2, voffA);
            PG8_BAR; PG8_WAIT_L(0); PG8_MMA(1, 0, At, B0); PG8_BAR; PG8_SCHED;
            PG8_STAGE(PG8_SB(0, 1), b2 + hstep, voffB);
            PG8_WAIT_V(6); PG8_BAR; PG8_MMA(1, 1, At, B1); PG8_BAR;
            PG8_LDB(B0, 1, 0); PG8_SCHED; PG8_LDA(At, 1, 0); PG8_STAGE(PG8_SA(0, 1), a2 + hstep, voffA);
            PG8_WAIT_L(8); PG8_BAR; PG8_WAIT_L(0); PG8_MMA(0, 0, At, B0); PG8_BAR; PG8_SCHED;
            PG8_LDB(B1, 1, 1); PG8_STAGE(PG8_SB(1, 0), b3, voffB);
            PG8_BAR; PG8_WAIT_L(0); PG8_MMA(0, 1, At, B1); PG8_BAR;
            PG8_LDA(At, 1, 1); PG8_STAGE(PG8_SA(1, 0), a3, voffA);
            PG8_BAR; PG8_WAIT_L(0); PG8_MMA(1, 0, At, B0); PG8_BAR; PG8_SCHED;
            PG8_STAGE(PG8_SB(1, 1), b3 + hstep, voffB);
            PG8_WAIT_V(6); PG8_BAR; PG8_MMA(1, 1, At, B1); PG8_BAR;
            }
        }
        if constexpr (ALIGN_EPI) { if (wr == 0) PG8_BAR; }
        if constexpr (!Epi::AFTER_DRAIN) { E(acc, cur, wr, wc, fr, fq); S.done(cur); }
        if (!has_next) break;
#pragma unroll
        for (int a = 0; a < 2; ++a)
#pragma unroll
            for (int b = 0; b < 2; ++b)
#pragma unroll
                for (int m = 0; m < 4; ++m)
#pragma unroll
                    for (int n = 0; n < 2; ++n) acc[a][b][m][n] = (f32x4){0.f, 0.f, 0.f, 0.f};
        cur = nxt; cA = nA; cB = nB; ++ui;
        if constexpr (ALIGN_EPI) { if (wr == 1) PG8_BAR; }
    }
    PG8_WAIT_V(0);
    if constexpr (!ALIGN_EPI) { if (wr == 0) PG8_BAR; }
    PG8_BAR;
    if constexpr (Epi::AFTER_DRAIN) { E.fused(acc, cur, wr, wc, fr, fq, lds, wid, lane); S.done(cur); }
#undef PG8_SA
#undef PG8_SB
#undef PG8_STAGE
#undef PG8_LDA
#undef PG8_LDB
#undef PG8_MMA
#undef PG8_WAIT_V
#undef PG8_WAIT_L
#undef PG8_BAR
#undef PG8_SCHED
}
}

#define DI __device__ __forceinline__
#define LAS __attribute__((address_space(3)))
using pg8::bf16_t; using pg8::f32x4; using pg8::bf16x8; using pg8::u32x4; using pg8::Unit; using pg8::f32x2;
typedef float f32x16 __attribute__((ext_vector_type(16)));
typedef short s16x4 __attribute__((ext_vector_type(4)));
typedef unsigned u32x2 __attribute__((ext_vector_type(2)));

constexpr int T = 16384, SEQ = 8192, DM = 1024, FF = 2816;
constexpr int NWIN = 2304, NGATE = 3072;
constexpr float EPS = 1e-6f;
constexpr float LOG2E = 1.4426950408889634f;
constexpr float QSCALE_MLA = 0.10206207261596575f * LOG2E;
constexpr float QSCALE_MEM = 0.08838834764831845f * LOG2E;

constexpr size_t MiB = 1u << 20;
constexpr size_t W_GU1 = 0, W_DN1 = 11 * MiB, W_IN = W_DN1 + 5632 * 1024, W_GT = W_IN + (size_t)NWIN * 2048, W_UQ = 27 * MiB + 512 * 1024, W_UKV = 28 * MiB + 512 * 1024,
                 W_MKV = 29 * MiB, W_BA = 31 * MiB, W_BB = 32 * MiB, W_BC = 33 * MiB, W_OUT = 34 * MiB, W_GU2 = 36 * MiB, W_DN2 = 47 * MiB, W_SG = 53 * MiB;
static_assert(W_GT + (size_t)NGATE * 2048 <= W_UQ && W_UQ + 768 * 384 * 2 <= W_UKV && W_DN2 + 5632 * 1024 <= W_SG, "weight map");
constexpr size_t S_SS1 = 54 * MiB, S_SS2 = 55 * MiB, S_VST = 56 * MiB, S_CQP = 58 * MiB, S_CKVP = 59 * MiB, S_QMP = 60 * MiB, S_KR = 61 * MiB,
                 S_MEMN = 63 * MiB, S_MKV = 64 * MiB, S_KM = 66 * MiB, S_VMT = 66 * MiB + 512 * 1024;
constexpr size_t S_BAR = 53 * MiB + 512 * 1024;
constexpr size_t S_R0 = 53 * MiB + 384 * 1024;
constexpr size_t S_DUMMY = 53 * MiB + 256 * 1024;
constexpr size_t BIG = 67 * MiB;
constexpr size_t B_X1B = BIG, B_MG = BIG, B_U = BIG + 32 * MiB, B_YB = BIG + 48 * MiB, B_YC = BIG + 64 * MiB, B_VG = BIG + 48 * MiB, B_CQ = BIG + 64 * MiB, B_CKV = BIG + 76 * MiB,
                 B_QM = BIG + 84 * MiB, B_QRAW = BIG + 100 * MiB, B_K = BIG + 124 * MiB, B_VT = BIG + 148 * MiB, B_KN = BIG + 164 * MiB,
                 B_G0 = BIG + 80 * MiB, B_G1 = BIG + 112 * MiB, B_G2 = BIG + 144 * MiB, B_ACT = BIG + 32 * MiB, B_XB = BIG + 120 * MiB, B_X2B = BIG + 120 * MiB;
static_assert(B_G1 - B_G0 == 32 * MiB && B_G2 - B_G1 == 32 * MiB, "gate buffers 32 MiB apart");
constexpr size_t WS_NEED = BIG + 184 * MiB;

DI unsigned f2bf(float f) { unsigned u = __builtin_bit_cast(unsigned, f); return (u + 0x7fffu + ((u >> 16) & 1u)) >> 16; }
DI unsigned pk2(float lo, float hi) { typedef float v2f __attribute__((ext_vector_type(2))); typedef __bf16 v2b __attribute__((ext_vector_type(2))); v2f v = {lo, hi}; v2b b = __builtin_convertvector(v, v2b); return __builtin_bit_cast(unsigned, b); }
DI float bflo(unsigned w) { return __uint_as_float(w << 16); }
DI float bfhi(unsigned w) { return __uint_as_float(w & 0xffff0000u); }
DI float sigmoidf_(float v) { return __builtin_amdgcn_rcpf(1.0f + __expf(-v)); }
DI float siluf_(float v) { return v * sigmoidf_(v); }

template <int NP> DI float row_rstd(const float* P, int row, float invn) {
    if (NP == 0) return 1.0f;
    return __builtin_amdgcn_rsqf(P[row] * invn + EPS);
}
DI void atomic_addf(float* p, float v) { __builtin_amdgcn_global_atomic_fadd_f32((__attribute__((address_space(1))) float*)p, v); }
DI float quad_sum(float s) { s += __shfl_xor(s, 16); s += __shfl_xor(s, 32); return s; }

template <int NP> struct EpiSwiglu {
    static constexpr bool PERM = true, AFTER_DRAIN = false;
    bf16_t* O; const float* P;
    DI void operator()(const f32x4 (&acc)[2][2][4][2], const Unit& u, int wr, int wc, int fr, int fq) const {
        const int row0 = u.pm * 256 + wr * 64 + fr, col0 = u.pn * 128 + wc * 32 + 8 * fq;
#pragma unroll
        for (int ai = 0; ai < 2; ++ai)
#pragma unroll
            for (int m = 0; m < 4; ++m) {
                const int row = row0 + ai * 128 + m * 16; const float rs = row_rstd<NP>(P, row, 1.0f / 1024.0f);
                float a[8];
#pragma unroll
                for (int n = 0; n < 2; ++n)
#pragma unroll
                    for (int i = 0; i < 4; ++i) { const float g = acc[ai][0][m][n][i] * rs, uu = acc[ai][1][m][n][i] * rs; a[4 * n + i] = siluf_(g) * uu; }
                u32x4 w; w.x = pk2(a[0], a[1]); w.y = pk2(a[2], a[3]); w.z = pk2(a[4], a[5]); w.w = pk2(a[6], a[7]);
                *(u32x4*)(O + (size_t)row * FF + col0) = w;
            }
    }
};
template <bool WB, bool B16, bool WOUT> struct EpiResid {
    static constexpr bool PERM = true, AFTER_DRAIN = false;
    const float* base  ; const bf16_t* base16; float* out; bf16_t* xb; float* P; float alpha;
    DI void operator()(const f32x4 (&acc)[2][2][4][2], const Unit& u, int wr, int wc, int fr, int fq) const {
        const int row0 = u.pm * 256 + wr * 64 + fr, col0 = u.pn * 256 + wc * 32 + 8 * fq;
#pragma unroll
        for (int ai = 0; ai < 2; ++ai)
#pragma unroll
            for (int m = 0; m < 4; ++m) {
                const int row = row0 + ai * 128 + m * 16; float ss = 0.f;
                const float bs = (B16 && base) ? base[row] : 1.0f;
#pragma unroll
                for (int bj = 0; bj < 2; ++bj) {
                    const size_t off = (size_t)row * DM + col0 + bj * 128;
                    f32x4 b0, b1;
                    if (B16) { const u32x4 bb = *(const u32x4*)(base16 + off); b0 = (f32x4){bflo(bb.x), bfhi(bb.x), bflo(bb.y), bfhi(bb.y)}; b1 = (f32x4){bflo(bb.z), bfhi(bb.z), bflo(bb.w), bfhi(bb.w)}; b0 = b0 * bs; b1 = b1 * bs; }
                    else { b0 = *(const f32x4*)(base + off); b1 = *(const f32x4*)(base + off + 4); }
                    const f32x4 o0 = b0 + acc[ai][bj][m][0] * alpha, o1 = b1 + acc[ai][bj][m][1] * alpha;
                    if (WOUT) { *(f32x4*)(out + off) = o0; *(f32x4*)(out + off + 4) = o1; }
                    if (WB) { ss += (o0[0] * o0[0] + o0[1] * o0[1]) + (o0[2] * o0[2] + o0[3] * o0[3]) + (o1[0] * o1[0] + o1[1] * o1[1]) + (o1[2] * o1[2] + o1[3] * o1[3]);
                        u32x4 w; w.x = pk2(o0[0], o0[1]); w.y = pk2(o0[2], o0[3]); w.z = pk2(o1[0], o1[1]); w.w = pk2(o1[2], o1[3]); *(u32x4*)(xb + off) = w; }
                }
                if (WB) { ss = quad_sum(ss); if (fq == 0) atomic_addf(P + row, ss); }
            }
    }
};
struct EpiWin {
    static constexpr bool PERM = true, AFTER_DRAIN = false;
    const float* P; bf16_t *U, *Vg, *CQ, *CKV, *QM; float *KR, *VST, *CQP, *CKVP, *QMP;
    DI void operator()(const f32x4 (&acc)[2][2][4][2], const Unit& u, int wr, int wc, int fr, int fq) const {
        const int row0 = u.pm * 256 + wr * 64 + fr, cw = wc * 32 + 8 * fq;
#pragma unroll
        for (int ai = 0; ai < 2; ++ai)
#pragma unroll
            for (int m = 0; m < 4; ++m) {
                const int row = row0 + ai * 128 + m * 16; const float rs = row_rstd<16>(P, row, 1.0f / 1024.0f);
#pragma unroll
                for (int bj = 0; bj < 2; ++bj) {
                    const int c128 = u.pn * 256 + bj * 128;
                    float v[8];
#pragma unroll
                    for (int n = 0; n < 2; ++n)
#pragma unroll
                        for (int i = 0; i < 4; ++i) v[4 * n + i] = acc[ai][bj][m][n][i] * rs;
                    if (c128 < 1024) {
#pragma unroll
                        for (int i = 0; i < 8; i += 2) { const f32x2 g = pg8::gelu_pk((f32x2){v[i], v[i + 1]}); v[i] = g.x; v[i + 1] = g.y; }
                        const bool isv = c128 >= 512;
                        u32x4 w; w.x = pk2(v[0], v[1]); w.y = pk2(v[2], v[3]); w.z = pk2(v[4], v[5]); w.w = pk2(v[6], v[7]);
                        *(u32x4*)((isv ? Vg : U) + (size_t)row * 512 + (c128 & 511) + cw) = w;
                        if (isv) {
                            float s1 = 0.f, s2 = 0.f;
#pragma unroll
                            for (int i = 0; i < 8; ++i) { s1 += v[i]; s2 += v[i] * v[i]; }
                            s1 = quad_sum(s1); s2 = quad_sum(s2);
                            if (fq == 0) { float* d = VST + ((size_t)row * 16 + ((c128 - 512) >> 7) * 4 + wc) * 2; d[0] = s1; d[1] = s2; }
                        }
                    } else if (c128 < 2176) {
                        bf16_t* dst; float* pp; const bool isqm = c128 >= 1664;
                        if (c128 < 1408) { dst = CQ + (size_t)row * 384 + (c128 - 1024); pp = CQP + row; }
                        else if (c128 < 1664) { dst = CKV + (size_t)row * 256 + (c128 - 1408); pp = CKVP + row; }
                        else { dst = QM + (size_t)row * 512 + (c128 - 1664); pp = QMP + (size_t)row * 16 + ((c128 - 1664) >> 7) * 4 + wc; }
                        u32x4 w; w.x = pk2(v[0], v[1]); w.y = pk2(v[2], v[3]); w.z = pk2(v[4], v[5]); w.w = pk2(v[6], v[7]);
                        *(u32x4*)(dst + cw) = w;
                        float s2 = 0.f;
#pragma unroll
                        for (int i = 0; i < 8; ++i) s2 += v[i] * v[i];
                        s2 = quad_sum(s2);
                        if (fq == 0) { if (isqm) *pp = s2; else atomic_addf(pp, s2); }
                    } else if (c128 == 2176) {
                        if (wc == 0) { float* d = KR + (size_t)row * 32 + 8 * fq; *(f32x4*)d = (f32x4){v[0], v[1], v[2], v[3]}; *(f32x4*)(d + 4) = (f32x4){v[4], v[5], v[6], v[7]}; }
                    }
                }
            }
    }
};
struct EpiGate {
    static constexpr bool PERM = true, AFTER_DRAIN = false;
    const float* P; const float* bias; bf16_t* G0;
    DI void operator()(const f32x4 (&acc)[2][2][4][2], const Unit& u, int wr, int wc, int fr, int fq) const {
        const int row0 = u.pm * 256 + wr * 64 + fr, br = u.pn >> 2, cw = (u.pn & 3) * 256 + wc * 32 + 8 * fq;
        bf16_t* G = G0 + (size_t)br * (16u << 20);
        f32x4 bv[2][2];
#pragma unroll
        for (int bj = 0; bj < 2; ++bj)
#pragma unroll
            for (int n = 0; n < 2; ++n) bv[bj][n] = *(const f32x4*)(bias + br * 1024 + cw + bj * 128 + 4 * n);
#pragma unroll
        for (int ai = 0; ai < 2; ++ai)
#pragma unroll
            for (int m = 0; m < 4; ++m) {
                const int row = row0 + ai * 128 + m * 16; const float rs = row_rstd<16>(P, row, 1.0f / 1024.0f);
#pragma unroll
                for (int bj = 0; bj < 2; ++bj) {
                    float v[8];
#pragma unroll
                    for (int n = 0; n < 2; ++n)
#pragma unroll
                        for (int i = 0; i < 4; ++i) v[4 * n + i] = sigmoidf_(acc[ai][bj][m][n][i] * rs + bv[bj][n][i]);
                    u32x4 w; w.x = pk2(v[0], v[1]); w.y = pk2(v[2], v[3]); w.z = pk2(v[4], v[5]); w.w = pk2(v[6], v[7]);
                    *(u32x4*)(G + (size_t)row * DM + cw + bj * 128) = w;
                }
            }
    }
};
struct EpiUq {
    static constexpr bool PERM = true, AFTER_DRAIN = false;
    const float* P; bf16_t* O;
    DI void operator()(const f32x4 (&acc)[2][2][4][2], const Unit& u, int wr, int wc, int fr, int fq) const {
        const int row0 = u.pm * 256 + wr * 64 + fr, cw = u.pn * 256 + wc * 32 + 8 * fq;
#pragma unroll
        for (int ai = 0; ai < 2; ++ai)
#pragma unroll
            for (int m = 0; m < 4; ++m) {
                const int row = row0 + ai * 128 + m * 16; const float rs = row_rstd<1>(P, row, 1.0f / 384.0f);
#pragma unroll
                for (int bj = 0; bj < 2; ++bj) {
                    const f32x4 a = acc[ai][bj][m][0] * rs, b = acc[ai][bj][m][1] * rs;
                    u32x4 w; w.x = pk2(a[0], a[1]); w.y = pk2(a[2], a[3]); w.z = pk2(b[0], b[1]); w.w = pk2(b[2], b[3]);
                    *(u32x4*)(O + (size_t)row * 768 + cw + bj * 128) = w;
                }
            }
    }
};
struct EpiUkv {
    static constexpr bool PERM = true, AFTER_DRAIN = false;
    const float* P; bf16_t* KN; bf16_t* Vt;
    DI void operator()(const f32x4 (&acc)[2][2][4][2], const Unit& u, int wr, int wc, int fr, int fq) const {
        const int row0 = u.pm * 256 + wr * 64 + fr;
#pragma unroll
        for (int ai = 0; ai < 2; ++ai)
#pragma unroll
            for (int m = 0; m < 4; ++m) {
                const int row = row0 + ai * 128 + m * 16; const float rs = row_rstd<1>(P, row, 1.0f / 256.0f);
                const int b = row >> 13, s = row & 8191;
#pragma unroll
                for (int bj = 0; bj < 2; ++bj) {
                    const int h = u.pn * 2 + bj;
                    const f32x4 a = acc[ai][bj][m][0] * rs, c = acc[ai][bj][m][1] * rs;
                    if (wc < 2) {
                        u32x4 w; w.x = pk2(a[0], a[1]); w.y = pk2(a[2], a[3]); w.z = pk2(c[0], c[1]); w.w = pk2(c[2], c[3]);
                        *(u32x4*)(KN + (size_t)row * 512 + h * 64 + wc * 32 + 8 * fq) = w;
                    } else {
                        const unsigned vo = (unsigned)((b * 8 + h) * 64 + (wc - 2) * 32 + 8 * fq) * (unsigned)SEQ + (unsigned)s;
#pragma unroll
                        for (int i = 0; i < 4; ++i) { Vt[vo + (unsigned)(i * SEQ)] = (bf16_t)f2bf(a[i]); Vt[vo + (unsigned)((4 + i) * SEQ)] = (bf16_t)f2bf(c[i]); }
                    }
                }
            }
    }
};
struct EpiF32 {
    static constexpr bool PERM = true, AFTER_DRAIN = false;
    float* O; int ldc;
    DI void operator()(const f32x4 (&acc)[2][2][4][2], const Unit& u, int wr, int wc, int fr, int fq) const {
        const int row0 = u.pm * 256 + wr * 64 + fr, col0 = u.pn * 256 + wc * 32 + 8 * fq;
#pragma unroll
        for (int ai = 0; ai < 2; ++ai)
#pragma unroll
            for (int m = 0; m < 4; ++m)
#pragma unroll
                for (int bj = 0; bj < 2; ++bj)
#pragma unroll
                    for (int n = 0; n < 2; ++n) *(f32x4*)(O + (size_t)(row0 + ai * 128 + m * 16) * ldc + col0 + bj * 128 + n * 4) = acc[ai][bj][m][n];
    }
};
struct GateOrder {
    pg8::StaticOrder base;
    __device__ bool next(int i, Unit& u) const { Unit b; if (!base.next(i / 3, b)) return false; u.pm = b.pm; u.pn = b.pn + 4 * (i % 3); return true; }
    DI void a_ready(const Unit&) const {}
    DI void done(const Unit&) const {}
};
struct BranchOrder {
    pg8::StaticOrder base;
    __device__ bool next(int i, Unit& u) const { Unit b; if (!base.next(i / 3, b)) return false; const int br = i % 3; u.pm = b.pm + 64 * br; u.pn = b.pn + 4 * br; return true; }
    DI void a_ready(const Unit&) const {}
    DI void done(const Unit&) const {}
};
struct EpiBranch {
    static constexpr bool PERM = true, AFTER_DRAIN = false;
    const bf16_t* G0; bf16_t* MG;
    DI void operator()(const f32x4 (&acc)[2][2][4][2], const Unit& u, int wr, int wc, int fr, int fq) const {
        const int br = u.pm >> 6, row0 = (u.pm & 63) * 256 + wr * 64 + fr, col0 = (u.pn & 3) * 256 + wc * 32 + 8 * fq;
        const bf16_t* G = G0 + (size_t)br * (16u << 20);
#pragma unroll
        for (int ai = 0; ai < 2; ++ai)
#pragma unroll
            for (int m = 0; m < 4; ++m)
#pragma unroll
                for (int bj = 0; bj < 2; ++bj) {
                    const size_t off = (size_t)(row0 + ai * 128 + m * 16) * DM + col0 + bj * 128;
                    const u32x4 g = *(const u32x4*)(G + off); const f32x4 a = acc[ai][bj][m][0], b = acc[ai][bj][m][1];
                    float o[8] = {bflo(g.x) * a[0], bfhi(g.x) * a[1], bflo(g.y) * a[2], bfhi(g.y) * a[3], bflo(g.z) * b[0], bfhi(g.z) * b[1], bflo(g.w) * b[2], bfhi(g.w) * b[3]};
                    if (br > 0) { const u32x4 p = *(const u32x4*)(MG + off); o[0] += bflo(p.x); o[1] += bfhi(p.x); o[2] += bflo(p.y); o[3] += bfhi(p.y); o[4] += bflo(p.z); o[5] += bfhi(p.z); o[6] += bflo(p.w); o[7] += bfhi(p.w); }
                    u32x4 w; w.x = pk2(o[0], o[1]); w.y = pk2(o[2], o[3]); w.z = pk2(o[4], o[5]); w.w = pk2(o[6], o[7]); *(u32x4*)(MG + off) = w;
                }
    }
};

__constant__ float ROPE_INV[16] = {1.0f, 0.5623413324356079f, 0.3162277638912201f, 0.17782793939113617f, 0.10000000149011612f, 0.05623413249850273f, 0.03162277489900589f, 0.017782794311642647f,
                                   0.009999999776482582f, 0.005623413249850273f, 0.003162277629598975f, 0.0017782794311642647f, 0.0010000000474974513f, 0.000562341301701963f, 0.0003162277571391314f, 0.00017782794020604342f};
#define MFMA32(a, b, c) __builtin_amdgcn_mfma_f32_32x32x16_bf16((a), (b), (c), 0, 0, 0)
DI float xhalf_max(float m) { auto rr = __builtin_amdgcn_permlane32_swap(__float_as_uint(m), __float_as_uint(m), false, false); return __builtin_fmaxf(__uint_as_float(rr[0]), __uint_as_float(rr[1])); }
DI float xhalf_sum(float m) { auto rr = __builtin_amdgcn_permlane32_swap(__float_as_uint(m), __float_as_uint(m), false, false); return __uint_as_float(rr[0]) + __uint_as_float(rr[1]); }
template <int DQK, int DV, bool CAUSAL, int KT, bool PRIO>
DI void attn_unit(const bf16_t* Qb, int qpitch, const bf16_t* Kb, int kpitch, const bf16_t* Vtb, int vpitch, bf16_t* Ob, int opitch, int q0, int nt, LAS unsigned char* lds, float kbound, const float* qgain, const int* qpos, float qscale) {
    constexpr int KS = DQK * 2 + 16, VS = KT * 2 + 8, KBUF = KT * KS, VBUF = DV * VS, VOFF = 2 * KBUF;
    constexpr int KCH = DQK / 8, NKC = KT * KCH, NKR = (NKC + 511) / 512, VCH = KT / 8, NVC = DV * VCH, NVR = NVC / 512;
    constexpr float THR = 8.0f;
    static_assert(NVC % 512 == 0 && VOFF + 2 * VBUF <= 131072, "attention staging geometry");
    int tid_ = threadIdx.x; asm volatile("" : "+v"(tid_));
    const int tid = tid_, lane = tid & 63, r = lane & 31, h = lane >> 5, w = __builtin_amdgcn_readfirstlane(tid >> 6);
    u32x4 kreg[NKR], vreg[NVR];
    auto gload = [&](int kt) {
#pragma unroll
        for (int i = 0; i < NKR; ++i) { const int c = tid + i * 512; if (NKC % 512 == 0 || c < NKC) kreg[i] = *(const u32x4*)(Kb + (size_t)(kt * KT + c / KCH) * kpitch + (c % KCH) * 8); }
#pragma unroll
        for (int i = 0; i < NVR; ++i) { const int c = tid + i * 512; vreg[i] = *(const u32x4*)(Vtb + (size_t)(c / VCH) * vpitch + kt * KT + (c % VCH) * 8); }
    };
    auto lstore = [&](int buf) {
#pragma unroll
        for (int i = 0; i < NKR; ++i) { const int c = tid + i * 512; if (NKC % 512 == 0 || c < NKC) *(LAS u32x4*)(lds + buf * KBUF + (c / KCH) * KS + (c % KCH) * 16) = kreg[i]; }
#pragma unroll
        for (int i = 0; i < NVR; ++i) { const int c = tid + i * 512; LAS unsigned char* p = lds + VOFF + buf * VBUF + (c / VCH) * VS + (c % VCH) * 16;
            *(LAS u32x2*)p = (u32x2){vreg[i].x, vreg[i].y}; *(LAS u32x2*)(p + 8) = (u32x2){vreg[i].z, vreg[i].w}; }
    };
    gload(0);
    bf16x8 qf[DQK / 16];
#pragma unroll
    for (int ks = 0; ks < DQK / 16; ++ks) qf[ks] = *(const bf16x8*)(Qb + (size_t)(32 * w + r) * qpitch + 16 * ks + 8 * h);
    if (qgain) {
        float v[DQK / 16][8]; float q2 = 0.f;
#pragma unroll
        for (int ks = 0; ks < DQK / 16; ++ks)
#pragma unroll
            for (int e = 0; e < 8; ++e) { v[ks][e] = __uint_as_float(((unsigned)(unsigned short)qf[ks][e]) << 16); q2 += v[ks][e] * v[ks][e]; }
        q2 = xhalf_sum(q2);
        const float rq = __builtin_amdgcn_rsqf(q2 * (1.0f / (float)DQK) + EPS) * qscale;
#pragma unroll
        for (int ks = 0; ks < DQK / 16; ++ks) { const f32x4 g0 = *(const f32x4*)(qgain + 16 * ks + 8 * h), g1 = *(const f32x4*)(qgain + 16 * ks + 8 * h + 4);
#pragma unroll
            for (int e = 0; e < 4; ++e) { v[ks][e] *= rq * g0[e]; v[ks][4 + e] *= rq * g1[e]; } }
        if (DQK == 96 && qpos) {
        const float pos = (float)qpos[32 * w + r];
#pragma unroll
        for (int e = 0; e < 8; ++e) {
            const float ang = pos * ROPE_INV[8 * h + e]; const double rev = (double)ang * 0.15915494309189535; const float f = (float)(rev - floor(rev));
            const float c = __builtin_amdgcn_cosf(f), sn_ = __builtin_amdgcn_sinf(f), x1 = v[4][e], x2 = v[5][e];
            v[4][e] = x1 * c - x2 * sn_; v[5][e] = x2 * c + x1 * sn_; }
        }
#pragma unroll
        for (int ks = 0; ks < DQK / 16; ++ks) { u32x4 pw; pw.x = pk2(v[ks][0], v[ks][1]); pw.y = pk2(v[ks][2], v[ks][3]); pw.z = pk2(v[ks][4], v[ks][5]); pw.w = pk2(v[ks][6], v[ks][7]); qf[ks] = __builtin_bit_cast(bf16x8, pw); }
    }
    f32x16 o[DV / 32], negm;
#pragma unroll
    for (int i = 0; i < 16; ++i) negm[i] = 0.f;
#pragma unroll
    for (int d = 0; d < DV / 32; ++d)
#pragma unroll
        for (int i = 0; i < 16; ++i) o[d][i] = 0.f;
    float mrun = 0.f, lrun = 0.f; bool first = true;
    bool nomax = false;
    if (PRIO) {
        float q2 = 0.f;
#pragma unroll
        for (int ks = 0; ks < DQK / 16; ++ks)
#pragma unroll
            for (int e = 0; e < 8; ++e) { const float v = __uint_as_float(((unsigned)(unsigned short)qf[ks][e]) << 16); q2 += v * v; }
        q2 = xhalf_sum(q2);
        nomax = __all(sqrtf(q2) * kbound <= 100.0f) != 0;
    }
    lstore(0);
    __syncthreads();
    const int qabs = q0 + 32 * w + r, qlo = q0 + 32 * w;
    for (int kt = 0; kt < nt; ++kt) {
        const int buf = kt & 1;
        if (kt + 1 < nt) gload(kt + 1);
#pragma unroll
        for (int hf = 0; hf < KT / 64; ++hf) {
            const int key0 = kt * KT + 64 * hf;
            if (!CAUSAL || key0 <= qlo + 31) {
                if (PRIO) {
                    constexpr int KSN = DQK / 16, NDB = DV / 32;
                    f32x16 s0 = negm, s1 = negm;
                    const LAS unsigned char* kb = lds + buf * KBUF + (64 * hf + r) * KS + h * 16;
                    const LAS unsigned char* vb = lds + VOFF + buf * VBUF + r * VS + h * 8 + 128 * hf;
                    bf16x8 kf0[KSN], kf1[KSN], vf[4][NDB];
#pragma unroll
                    for (int ks = 0; ks < KSN; ++ks) { kf0[ks] = *(const LAS bf16x8*)(kb + ks * 32); kf1[ks] = *(const LAS bf16x8*)(kb + 32 * KS + ks * 32); }
                    __builtin_amdgcn_sched_barrier(0); __builtin_amdgcn_s_setprio(1); __builtin_amdgcn_sched_barrier(0);
#pragma unroll
                    for (int ks = 0; ks < KSN; ++ks) { s0 = MFMA32(kf0[ks], qf[ks], s0); s1 = MFMA32(kf1[ks], qf[ks], s1); }
                    __builtin_amdgcn_sched_barrier(0); __builtin_amdgcn_s_setprio(0); __builtin_amdgcn_sched_barrier(0);
#pragma unroll
                    for (int q4 = 0; q4 < 4; ++q4)
#pragma unroll
                        for (int d = 0; d < NDB; ++d) { const LAS unsigned char* vp = vb + d * 32 * VS + q4 * 32;
                            const s16x4 lo = *(const LAS s16x4*)vp, hi = *(const LAS s16x4*)(vp + 16); vf[q4][d] = (bf16x8){lo[0], lo[1], lo[2], lo[3], hi[0], hi[1], hi[2], hi[3]}; }
                    if (CAUSAL && key0 + 63 > qlo) {
#pragma unroll
                        for (int i = 0; i < 16; ++i) { const int key = key0 + (i & 3) + 8 * (i >> 2) + 4 * h; if (key > qabs) s0[i] = -1e30f; if (key + 32 > qabs) s1[i] = -1e30f; }
                    }
                    if (!nomax) {
                    float ra = __builtin_fmaxf(__builtin_fmaxf(s0[0], s0[1]), s1[0]), rb = __builtin_fmaxf(__builtin_fmaxf(s0[2], s0[3]), s1[1]);
                    ra = __builtin_fmaxf(__builtin_fmaxf(ra, s1[2]), s1[3]);
#pragma unroll
                    for (int i = 4; i < 16; i += 4) { ra = __builtin_fmaxf(__builtin_fmaxf(ra, s0[i]), s0[i + 1]); rb = __builtin_fmaxf(__builtin_fmaxf(rb, s0[i + 2]), s0[i + 3]);
                        ra = __builtin_fmaxf(__builtin_fmaxf(ra, s1[i]), s1[i + 1]); rb = __builtin_fmaxf(__builtin_fmaxf(rb, s1[i + 2]), s1[i + 3]); }
                    float rm = __builtin_fmaxf(ra, rb);
                    rm = xhalf_max(rm);
                    if (first || __any(rm > THR)) {
                        const float dl = first ? rm : fmaxf(rm, 0.f), f = __builtin_amdgcn_exp2f(-dl);
                        mrun += dl; lrun *= f; first = false;
#pragma unroll
                        for (int i = 0; i < 16; ++i) { s0[i] -= dl; s1[i] -= dl; negm[i] = -mrun; }
#pragma unroll
                        for (int d = 0; d < NDB; ++d)
#pragma unroll
                            for (int i = 0; i < 16; ++i) o[d][i] *= f;
                    }
                    }
                    float ps = 0.f;
#pragma unroll
                    for (int i = 0; i < 16; ++i) { s0[i] = __builtin_amdgcn_exp2f(s0[i]); ps += s0[i]; asm volatile("" : "+v"(ps)); }
#pragma unroll
                    for (int i = 0; i < 16; ++i) { s1[i] = __builtin_amdgcn_exp2f(s1[i]); ps += s1[i]; asm volatile("" : "+v"(ps)); }
                    lrun += ps;
                    bf16x8 pf[4];
#pragma unroll
                    for (int sf = 0; sf < 2; ++sf) {
                        u32x4 pw; pw.x = pk2(s0[8 * sf], s0[8 * sf + 1]); pw.y = pk2(s0[8 * sf + 2], s0[8 * sf + 3]); pw.z = pk2(s0[8 * sf + 4], s0[8 * sf + 5]); pw.w = pk2(s0[8 * sf + 6], s0[8 * sf + 7]); pf[sf] = __builtin_bit_cast(bf16x8, pw);
                        u32x4 pv; pv.x = pk2(s1[8 * sf], s1[8 * sf + 1]); pv.y = pk2(s1[8 * sf + 2], s1[8 * sf + 3]); pv.z = pk2(s1[8 * sf + 4], s1[8 * sf + 5]); pv.w = pk2(s1[8 * sf + 6], s1[8 * sf + 7]); pf[2 + sf] = __builtin_bit_cast(bf16x8, pv);
                    }
                    __builtin_amdgcn_sched_barrier(0); __builtin_amdgcn_s_setprio(1); __builtin_amdgcn_sched_barrier(0);
#pragma unroll
                    for (int q4 = 0; q4 < 4; ++q4)
#pragma unroll
                        for (int d = 0; d < NDB; ++d) o[d] = MFMA32(vf[q4][d], pf[q4], o[d]);
                    __builtin_amdgcn_sched_barrier(0); __builtin_amdgcn_s_setprio(0); __builtin_amdgcn_sched_barrier(0);
                } else {
                    f32x16 s0, s1;
                    if (PRIO) { s0 = negm; s1 = negm; } else {
#pragma unroll
                        for (int i = 0; i < 16; ++i) { s0[i] = 0.f; s1[i] = 0.f; } }
                    const LAS unsigned char* kb = lds + buf * KBUF + (64 * hf + r) * KS + h * 16;
                    if (PRIO) __builtin_amdgcn_s_setprio(1);
#pragma unroll
                    for (int ks = 0; ks < DQK / 16; ++ks) {
                        const bf16x8 a0 = *(const LAS bf16x8*)(kb + ks * 32), a1 = *(const LAS bf16x8*)(kb + 32 * KS + ks * 32);
                        s0 = MFMA32(a0, qf[ks], s0); s1 = MFMA32(a1, qf[ks], s1);
                    }
                    if (PRIO) __builtin_amdgcn_s_setprio(0);
                    if (CAUSAL && key0 + 63 > qlo) {
#pragma unroll
                        for (int i = 0; i < 16; ++i) { const int key = key0 + (i & 3) + 8 * (i >> 2) + 4 * h; if (key > qabs) s0[i] = -1e30f; if (key + 32 > qabs) s1[i] = -1e30f; }
                    }
                    if (!PRIO) {
#pragma unroll
                        for (int i = 0; i < 16; ++i) { s0[i] -= mrun; s1[i] -= mrun; } }
                    float rm = fmaxf(s0[0], s1[0]);
#pragma unroll
                    for (int i = 1; i < 16; ++i) rm = fmaxf(rm, fmaxf(s0[i], s1[i]));
                    rm = xhalf_max(rm);
                    if (first || __any(rm > THR)) {
                        const float dl = first ? rm : fmaxf(rm, 0.f), f = __builtin_amdgcn_exp2f(-dl);
                        mrun += dl; lrun *= f; first = false;
#pragma unroll
                        for (int i = 0; i < 16; ++i) { s0[i] -= dl; s1[i] -= dl; if (PRIO) negm[i] = -mrun; }
#pragma unroll
                        for (int d = 0; d < DV / 32; ++d)
#pragma unroll
                            for (int i = 0; i < 16; ++i) o[d][i] *= f;
                    }
                    const LAS unsigned char* vb = lds + VOFF + buf * VBUF + r * VS + h * 8 + 128 * hf;
                    float ps = 0.f;
#pragma unroll
                    for (int kb2 = 0; kb2 < 2; ++kb2) {
                        f32x16& sx = kb2 == 0 ? s0 : s1;
#pragma unroll
                        for (int i = 0; i < 16; ++i) { sx[i] = __builtin_amdgcn_exp2f(sx[i]); ps += sx[i]; }
                        if (PRIO) __builtin_amdgcn_s_setprio(1);
#pragma unroll
                        for (int sf = 0; sf < 2; ++sf) {
                            u32x4 pw; pw.x = pk2(sx[8 * sf], sx[8 * sf + 1]); pw.y = pk2(sx[8 * sf + 2], sx[8 * sf + 3]); pw.z = pk2(sx[8 * sf + 4], sx[8 * sf + 5]); pw.w = pk2(sx[8 * sf + 6], sx[8 * sf + 7]);
                            const bf16x8 pf = __builtin_bit_cast(bf16x8, pw);
#pragma unroll
                            for (int d = 0; d < DV / 32; ++d) {
                                const LAS unsigned char* vp = vb + d * 32 * VS + (32 * kb2 + 16 * sf) * 2;
                                const s16x4 lo = *(const LAS s16x4*)vp, hi = *(const LAS s16x4*)(vp + 16);
                                const bf16x8 a = (bf16x8){lo[0], lo[1], lo[2], lo[3], hi[0], hi[1], hi[2], hi[3]};
                                o[d] = MFMA32(a, pf, o[d]);
                                if (!PRIO) asm volatile("" ::: "memory");
                            }
                        }
                        if (PRIO) __builtin_amdgcn_s_setprio(0);
                    }
                    lrun += ps;
                }
            }
        }
        if (kt + 1 < nt) lstore(buf ^ 1);
        __syncthreads();
    }
    lrun = xhalf_sum(lrun);
    const float inv = 1.0f / lrun;
    bf16_t* orow = Ob + (size_t)(32 * w + r) * opitch;
#pragma unroll
    for (int d = 0; d < DV / 32; ++d)
#pragma unroll
        for (int g = 0; g < 4; ++g) { u32x2 wv; wv.x = pk2(o[d][4 * g] * inv, o[d][4 * g + 1] * inv); wv.y = pk2(o[d][4 * g + 2] * inv, o[d][4 * g + 3] * inv);
            *(u32x2*)(orow + 32 * d + 8 * g + 4 * h) = wv; }
}

#define MFMA16(a, b, c) __builtin_amdgcn_mfma_f32_16x16x32_bf16((a), (b), (c), 0, 0, 0)
DI void sgu_item(int g, int bc, int par, const bf16_t* SGW, const bf16_t* Vg, const float* VST, const float* lng, const float* lnb, const float* sgb, bf16_t* U, LAS unsigned char* lds) {
    constexpr int RS = 272;
    const int tid = threadIdx.x, lane = tid & 63, w = __builtin_amdgcn_readfirstlane(tid >> 6), row0 = bc * 128;
    LAS unsigned char* Wl = lds + par * (192 * RS); LAS unsigned char* Vl = Wl + 128 * RS;
    const int j = lane & 15, q = lane >> 4, t0 = 16 * w, nks = (t0 + 15) / 32 + 1, t = t0 + j;
    u32x4 wreg[4];
#pragma unroll
    for (int i = 0; i < 4; ++i) { const int c = tid + i * 512, rr = c >> 4, cc = c & 15; wreg[i] = *(const u32x4*)(SGW + (size_t)g * 16384 + rr * 128 + cc * 8); }
    const int s = tid & 127, dg = tid >> 7, row = row0 + s;
    f32x4 pst[8];
#pragma unroll
    for (int i = 0; i < 8; ++i) pst[i] = *(const f32x4*)(VST + (size_t)row * 32 + 4 * i);
    const u32x4 a = *(const u32x4*)(Vg + (size_t)row * 512 + g * 64 + dg * 16), b = *(const u32x4*)(Vg + (size_t)row * 512 + g * 64 + dg * 16 + 8);
    bf16_t* up = U + (size_t)(row0 + t) * 512 + g * 64 + 4 * q;
    u32x2 uu[4];
#pragma unroll
    for (int db = 0; db < 4; ++db) uu[db] = *(const u32x2*)(up + 16 * db);
    const float bias = sgb[g * 128 + t];
#pragma unroll
    for (int i = 0; i < 4; ++i) { const int c = tid + i * 512, rr = c >> 4, cc = c & 15; *(LAS u32x4*)(Wl + rr * RS + cc * 16) = wreg[i]; }
    {
        float s1 = 0.f, s2 = 0.f;
#pragma unroll
        for (int i = 0; i < 8; ++i) { s1 += pst[i][0] + pst[i][2]; s2 += pst[i][1] + pst[i][3]; }
        const float mu = s1 * (1.0f / 512.0f), var = s2 * (1.0f / 512.0f) - mu * mu, rstd = __builtin_amdgcn_rsqf(fmaxf(var, 0.f) + EPS);
        const unsigned wd[8] = {a.x, a.y, a.z, a.w, b.x, b.y, b.z, b.w};
#pragma unroll
        for (int i = 0; i < 8; ++i) {
            const int d = dg * 16 + 2 * i, c = g * 64 + d;
            const float v0 = (bflo(wd[i]) - mu) * rstd * lng[c] + lnb[c], v1 = (bfhi(wd[i]) - mu) * rstd * lng[c + 1] + lnb[c + 1];
            *(LAS bf16_t*)(Vl + d * RS + s * 2) = (bf16_t)f2bf(v0); *(LAS bf16_t*)(Vl + (d + 1) * RS + s * 2) = (bf16_t)f2bf(v1);
        }
    }
    __syncthreads();
    f32x4 acc[4];
#pragma unroll
    for (int db = 0; db < 4; ++db) acc[db] = (f32x4){0.f, 0.f, 0.f, 0.f};
    for (int ks = 0; ks < nks; ++ks) {
        const bf16x8 bw = *(const LAS bf16x8*)(Wl + (t0 + j) * RS + (32 * ks + 8 * q) * 2);
#pragma unroll
        for (int db = 0; db < 4; ++db) { const bf16x8 av = *(const LAS bf16x8*)(Vl + (16 * db + j) * RS + (32 * ks + 8 * q) * 2); acc[db] = MFMA16(av, bw, acc[db]); }
    }
#pragma unroll
    for (int db = 0; db < 4; ++db) {
        u32x2 wv; wv.x = pk2(bflo(uu[db].x) * (acc[db][0] + bias), bfhi(uu[db].x) * (acc[db][1] + bias)); wv.y = pk2(bflo(uu[db].y) * (acc[db][2] + bias), bfhi(uu[db].y) * (acc[db][3] + bias));
        *(u32x2*)(up + 16 * db) = wv;
    }
}

DI float wave_sum(float v) {
#pragma unroll
    for (int o = 1; o < 64; o <<= 1) v += __shfl_xor(v, o);
    return v;
}
DI bf16_t* dest_rows(int mode, int n0, int K, bf16_t* d0, bf16_t* d1) {
    if (mode == 1) { const int isu = n0 >= FF ? 1 : 0, c = n0 - isu * FF; return d0 + (size_t)((c >> 7) * 256 + isu * 128 + (c & 127)) * K; }
    if (mode == 2) {
        if (n0 < 1664) return d0 + (size_t)n0 * K;
        if (n0 < 1696) return d0 + (size_t)(2176 + n0 - 1664) * K;
        if (n0 < 2208) return d0 + (size_t)(1664 + n0 - 1696) * K;
        return d1 + (size_t)(n0 - 2208) * K;
    }
    return d0 + (size_t)n0 * K;
}
DI void transpose_mat(const float* W, int K, int N, const float* gk, int mode, bf16_t* d0, bf16_t* d1, LAS float* scr, int gw, int ngw, int lane, int nb0 = 0, int nb1 = -1) {
    if (nb1 < 0) nb1 = N / 32;
    const int nblk = nb1 - nb0, nitems = (K / 64) * nblk;
    for (int item = gw; item < nitems; item += ngw) {
        const int kb = item / nblk, nb = nb0 + item % nblk, k0 = 64 * kb, n0 = 32 * nb;
        float tv[32];
#pragma unroll
        for (int i = 0; i < 32; ++i) { const int kk = 2 * i + (lane >> 5); tv[i] = W[(size_t)(k0 + kk) * N + n0 + (lane & 31)]; }
#pragma unroll
        for (int i = 0; i < 32; ++i) { const int kk = 2 * i + (lane >> 5); float v = tv[i]; if (gk) v *= gk[k0 + kk]; scr[kk * 33 + (lane & 31)] = v; }
        asm volatile("s_waitcnt lgkmcnt(0)" ::: "memory");
        bf16_t* dst = dest_rows(mode, n0, K, d0, d1);
        const int c = lane & 7;
#pragma unroll
        for (int jj = 0; jj < 4; ++jj) { const int n = (lane >> 3) + 8 * jj; const LAS float* s = scr + (8 * c) * 33 + n;
            u32x4 o; o.x = pk2(s[0 * 33], s[1 * 33]); o.y = pk2(s[2 * 33], s[3 * 33]); o.z = pk2(s[4 * 33], s[5 * 33]); o.w = pk2(s[6 * 33], s[7 * 33]);
            *(u32x4*)(dst + (size_t)n * K + k0 + 8 * c) = o; }
        asm volatile("s_waitcnt lgkmcnt(0)" ::: "memory");
    }
}
DI void rms_row_to_bf16(const float* xrow, const float* gain, bf16_t* orow, int lane) {
    const f32x4* xr = (const f32x4*)xrow + lane;
    f32x4 v[4]; float s = 0.f;
#pragma unroll
    for (int jj = 0; jj < 4; ++jj) { v[jj] = xr[64 * jj]; s += (v[jj][0] * v[jj][0] + v[jj][1] * v[jj][1]) + (v[jj][2] * v[jj][2] + v[jj][3] * v[jj][3]); }
    const float rstd = 1.0f / sqrtf(wave_sum(s) * (1.0f / 1024.0f) + EPS);
    u32x2* o8 = (u32x2*)orow + lane;
#pragma unroll
    for (int jj = 0; jj < 4; ++jj) {
        f32x4 gg = (f32x4){1.f, 1.f, 1.f, 1.f}; if (gain) gg = ((const f32x4*)gain)[lane + 64 * jj];
        u32x2 wv; wv.x = pk2(v[jj][0] * rstd * gg[0], v[jj][1] * rstd * gg[1]); wv.y = pk2(v[jj][2] * rstd * gg[2], v[jj][3] * rstd * gg[3]); o8[64 * jj] = wv;
    }
}

#define RLX_AGENT __ATOMIC_RELAXED, __HIP_MEMORY_SCOPE_AGENT
#define XB_TMO      128
#define XB_XCNT(j)  (256  + 64 * (j))
#define XB_XSUB(j)  (1280 + 64 * (j))
#define XB_XGEN(j)  (2304 + 64 * (j))
#define XB_TOP      3328
#define XB_TOPGEN   3392
#define XCD_BAR_WORDS 3456
#define XB_SPIN_CAP (1u << 18)

__device__ __forceinline__ unsigned xb_ld(unsigned* p)              { return __hip_atomic_load(p, __ATOMIC_RELAXED, __HIP_MEMORY_SCOPE_AGENT); }
__device__ __forceinline__ unsigned xb_add(unsigned* p, unsigned v) { return __hip_atomic_fetch_add(p, v, __ATOMIC_RELAXED, __HIP_MEMORY_SCOPE_AGENT); }
__device__ __forceinline__ unsigned xb_xcc_id() { return (unsigned)__builtin_amdgcn_s_getreg((3 << 11) | 20) & 0xFu; }
#define XB_SPIN(cond, bar) do { unsigned _sp = 0; while (cond) { __builtin_amdgcn_s_sleep(1); \
    if ((++_sp & 255u) == 0u) { if (xb_ld(&(bar)[XB_TMO])) break; if (_sp > XB_SPIN_CAP) { atomicAdd(&(bar)[XB_TMO], 1u); break; } } } } while (0)

struct XcdBarrier {
    unsigned* bar; unsigned x;
    volatile LAS unsigned* st;
};

__device__ __forceinline__ XcdBarrier xcd_barrier_post(unsigned* bar, volatile LAS unsigned* st) {
    XcdBarrier b; b.bar = bar; b.x = xb_xcc_id(); b.st = st;
    if (threadIdx.x == 0) (void)xb_add(&bar[XB_XCNT(b.x)], 1u);
    return b;
}
__device__ __forceinline__ void xcd_barrier_complete(unsigned* bar, unsigned x, unsigned& nloc, unsigned& nx) {
    const unsigned G = gridDim.x * gridDim.y * gridDim.z;
    unsigned sum, cnt, mine, sp = 0u;
    for (;;) {
        sum = 0u; cnt = 0u; mine = 0u;
#pragma unroll
        for (unsigned j = 0; j < 16; ++j) { const unsigned c = xb_ld(&bar[XB_XCNT(j)]); sum += c; cnt += (c > 0u) ? 1u : 0u; mine = (j == x) ? c : mine; }
        if (sum == G) break;
        __builtin_amdgcn_s_sleep(1);
        if ((++sp & 255u) == 0u) { if (xb_ld(&bar[XB_TMO])) break; if (sp > XB_SPIN_CAP) { atomicAdd(&bar[XB_TMO], 1u); break; } }
    }
    nloc = mine > 0u ? mine : 1u; nx = cnt > 0u ? cnt : 1u;
}

__device__ __forceinline__ void xcd_barrier(const XcdBarrier& b) {
    asm volatile("s_waitcnt vmcnt(0)" ::: "memory");
    __syncthreads();
    if (threadIdx.x == 0) {
        unsigned* bar = b.bar;
        __builtin_amdgcn_s_waitcnt(0);
        unsigned nloc = b.st[0], nx = b.st[1];
        if (nloc == 0u) { xcd_barrier_complete(bar, b.x, nloc, nx); b.st[0] = nloc; b.st[1] = nx; }
        const unsigned old = xb_add(&bar[XB_XSUB(b.x)], 1u);
        const unsigned gen = old / nloc;
        if (old + 1u == (gen + 1u) * nloc) {
            __builtin_amdgcn_fence(__ATOMIC_RELEASE, "agent");
            asm volatile("s_waitcnt vmcnt(0)" ::: "memory");
            const unsigned og = xb_add(&bar[XB_TOP], 1u);
            const unsigned tg = og / nx;
            if (og + 1u == (tg + 1u) * nx) xb_add(&bar[XB_TOPGEN], 1u);
            else XB_SPIN(xb_ld(&bar[XB_TOPGEN]) == tg, bar);
            __builtin_amdgcn_fence(__ATOMIC_ACQUIRE, "agent");
            xb_add(&bar[XB_XGEN(b.x)], 1u);
            asm volatile("s_waitcnt vmcnt(0)" ::: "memory");
        } else {
            XB_SPIN(xb_ld(&bar[XB_XGEN(b.x)]) == gen, bar);
            __builtin_amdgcn_fence(__ATOMIC_ACQUIRE, "agent");
            asm volatile("s_waitcnt vmcnt(0)" ::: "memory");
        }
    }
    __syncthreads();
}

struct Args { const float* in[30]; float* out; unsigned char* ws; int ph_lo, ph_hi; };
constexpr int LDS_BYTES = 135168;
constexpr int NPH = 12;


#define wGU1 ((bf16_t*)(ws + W_GU1))
#define wDN1 ((bf16_t*)(ws + W_DN1))
#define wIN ((bf16_t*)(ws + W_IN))
#define wGT ((bf16_t*)(ws + W_GT))
#define wUQ ((bf16_t*)(ws + W_UQ))
#define wUKV ((bf16_t*)(ws + W_UKV))
#define wMKV ((bf16_t*)(ws + W_MKV))
#define wBA ((bf16_t*)(ws + W_BA))
#define wBB ((bf16_t*)(ws + W_BB))
#define wBC ((bf16_t*)(ws + W_BC))
#define wOUT ((bf16_t*)(ws + W_OUT))
#define wGU2 ((bf16_t*)(ws + W_GU2))
#define wDN2 ((bf16_t*)(ws + W_DN2))
#define wSG ((bf16_t*)(ws + W_SG))
#define SS1 ((float*)(ws + S_SS1))
#define SS2 ((float*)(ws + S_SS2))
#define VST ((float*)(ws + S_VST))
#define CQP ((float*)(ws + S_CQP))
#define CKVP ((float*)(ws + S_CKVP))
#define QMP ((float*)(ws + S_QMP))
#define KR ((float*)(ws + S_KR))
#define MEMN ((bf16_t*)(ws + S_MEMN))
#define MKV ((float*)(ws + S_MKV))
#define KM ((bf16_t*)(ws + S_KM))
#define VMT ((bf16_t*)(ws + S_VMT))
#define X1B ((bf16_t*)(ws + B_X1B))
#define MG ((bf16_t*)(ws + B_MG))
#define U ((bf16_t*)(ws + B_U))
#define QM ((bf16_t*)(ws + B_QM))
#define VG ((bf16_t*)(ws + B_VG))
#define KF ((bf16_t*)(ws + B_K))
#define CQ ((bf16_t*)(ws + B_CQ))
#define CKV ((bf16_t*)(ws + B_CKV))
#define QRAW ((bf16_t*)(ws + B_QRAW))
#define KN ((bf16_t*)(ws + B_KN))
#define VT ((bf16_t*)(ws + B_VT))
#define YB ((bf16_t*)(ws + B_YB))
#define YC ((bf16_t*)(ws + B_YC))
#define G0 ((bf16_t*)(ws + B_G0))
#define G1 ((bf16_t*)(ws + B_G1))
#define G2 ((bf16_t*)(ws + B_G2))
#define ACT ((bf16_t*)(ws + B_ACT))
#define XB ((bf16_t*)(ws + B_XB))
#define X2B ((bf16_t*)(ws + B_X2B))
#define MGO ((bf16_t*)out)
DI unsigned char* opaque_ptr(unsigned char* p) { asm volatile("" : "+s"(p)); return p; }
__global__ void __launch_bounds__(512, 2) fwd_mega(Args args) {
    extern __shared__ __attribute__((aligned(16))) unsigned char lds_raw[];
    LAS unsigned char* lds = (LAS unsigned char*)lds_raw;
    cg::grid_group grid = cg::this_grid();
    const int tid = threadIdx.x, lane = tid & 63, wave = __builtin_amdgcn_readfirstlane(tid >> 6);
    const int G = gridDim.x, bx = blockIdx.x;
    const float* x = args.in[0]; const float* mem = args.in[1]; const int* positions = (const int*)args.in[2];
    float* out = args.out;
    const int lo = args.ph_lo, hi = args.ph_hi;
#ifndef PH_MASK
#define PH_MASK 0xFFF
#endif
#define IN(k) (((PH_MASK >> (k)) & 1) && lo <= (k) && (k) < hi)
#ifndef DUP_MASK
#define DUP_MASK 0
#endif
#define DUP(k) for (int rep_ = 0; rep_ < 1 + ((DUP_MASK >> (k)) & 1); ++rep_)
#define SEAM(k) do { if (IN(k) && IN((k) + 1)) xcd_barrier(xbar); } while (0)
    if (args.ph_lo < 0) grid.sync();
    if (tid < 4) ((LAS unsigned*)(lds + 131072 + 1024))[tid] = 0u;
    __syncthreads();
    XcdBarrier xbar = xcd_barrier_post((unsigned*)(args.ws + S_BAR), (volatile LAS unsigned*)(lds + 131072 + 1024));
    const int gw = bx * 8 + wave, ngw = G * 8, gt = bx * 512 + tid, ngt = G * 512;

    if (IN(0)) DUP(0) { unsigned char* ws = opaque_ptr(args.ws);
        LAS float* scr = (LAS float*)(lds + wave * 16384);
        const bool defer = (G == 256);
        transpose_mat(args.in[4], 1024, 5632, args.in[3], 1, wGU1, nullptr, scr, gw, ngw, lane);
        transpose_mat(args.in[20], 1024, 1024, nullptr, 0, wMKV, nullptr, scr, gw, ngw, lane);
        if (!defer) {
            transpose_mat(args.in[5], 2816, 1024, nullptr, 0, wDN1, nullptr, scr, gw, ngw, lane);
            transpose_mat(args.in[7], 1024, 5280, args.in[6], 2, wIN, wGT, scr, gw, ngw, lane);
            transpose_mat(args.in[14], 384, 768, args.in[13], 0, wUQ, nullptr, scr, gw, ngw, lane);
            transpose_mat(args.in[16], 256, 1024, args.in[15], 0, wUKV, nullptr, scr, gw, ngw, lane);
            transpose_mat(args.in[23], 512, 1024, nullptr, 0, wBA, nullptr, scr, gw, ngw, lane);
            transpose_mat(args.in[24], 512, 1024, nullptr, 0, wBB, nullptr, scr, gw, ngw, lane);
            transpose_mat(args.in[25], 512, 1024, nullptr, 0, wBC, nullptr, scr, gw, ngw, lane);
            transpose_mat(args.in[26], 1024, 1024, nullptr, 0, wOUT, nullptr, scr, gw, ngw, lane);
            transpose_mat(args.in[28], 1024, 5632, args.in[27], 1, wGU2, nullptr, scr, gw, ngw, lane);
            transpose_mat(args.in[29], 2816, 1024, nullptr, 0, wDN2, nullptr, scr, gw, ngw, lane);
        }
        for (int i = gt; i < 96 * 1024 / 8; i += ngt) ((u32x4*)(wIN + (size_t)2208 * 1024))[i] = (u32x4){0u, 0u, 0u, 0u};
        for (int i = gt; i < T; i += ngt) { SS1[i] = 0.f; SS2[i] = 0.f; CQP[i] = 0.f; CKVP[i] = 0.f; }
        for (int m = 2 * gw; m < T; m += 2 * ngw) {
            const f32x4* x0 = (const f32x4*)(x + (size_t)m * DM) + lane; const f32x4* x1 = x0 + DM / 4;
            f32x4 v0[4], v1[4]; float s0 = 0.f, s1 = 0.f;
#pragma unroll
            for (int jj = 0; jj < 4; ++jj) { v0[jj] = x0[64 * jj]; v1[jj] = x1[64 * jj]; }
#pragma unroll
            for (int jj = 0; jj < 4; ++jj) { s0 += (v0[jj][0] * v0[jj][0] + v0[jj][1] * v0[jj][1]) + (v0[jj][2] * v0[jj][2] + v0[jj][3] * v0[jj][3]);
                                             s1 += (v1[jj][0] * v1[jj][0] + v1[jj][1] * v1[jj][1]) + (v1[jj][2] * v1[jj][2] + v1[jj][3] * v1[jj][3]); }
            const float q0_ = sqrtf(wave_sum(s0) * (1.0f / 1024.0f) + EPS), q1_ = sqrtf(wave_sum(s1) * (1.0f / 1024.0f) + EPS), r0 = 1.0f / q0_, r1 = 1.0f / q1_;
            if (lane == 0) { ((float*)(ws + S_R0))[m] = q0_; ((float*)(ws + S_R0))[m + 1] = q1_; }
            u32x2* o0 = (u32x2*)(XB + (size_t)m * DM) + lane; u32x2* o1 = o0 + DM / 4;
#pragma unroll
            for (int jj = 0; jj < 4; ++jj) { u32x2 w0, w1; w0.x = pk2(v0[jj][0] * r0, v0[jj][1] * r0); w0.y = pk2(v0[jj][2] * r0, v0[jj][3] * r0); w1.x = pk2(v1[jj][0] * r1, v1[jj][1] * r1); w1.y = pk2(v1[jj][2] * r1, v1[jj][3] * r1);
                o0[64 * jj] = w0; o1[64 * jj] = w1; }
        }
        for (int m = gw; m < 512; m += ngw) rms_row_to_bf16(mem + (size_t)m * DM, args.in[19], MEMN + (size_t)m * DM, lane);
        { const float* sgw = args.in[11];
          for (int i = gt; i < 8 * 128 * 128 / 2; i += ngt) { const int e = 2 * i, s = e & 127, t = (e >> 7) & 127; const float a = s <= t ? sgw[e] : 0.f, b = (s + 1) <= t ? sgw[e + 1] : 0.f; ((unsigned*)wSG)[i] = pk2(a, b); } }
    }
    SEAM(0);
#ifdef EXTRA_SYNCS
    for (int i_ = 0; i_ < EXTRA_SYNCS; ++i_) xcd_barrier(xbar);
#endif
    if (IN(1)) DUP(1) { unsigned char* ws = opaque_ptr(args.ws);
        { pg8::Gemm g{XB, wGU1, T, 5632, 1024}; pg8::StaticOrder S; S.init(T, 5632, G, bx); EpiSwiglu<0> E{ACT, nullptr};
          pg8::gemm_phase<EpiSwiglu<0>, pg8::StaticOrder, true, true>(lds, g, S, E); }
        { pg8::Gemm g{MEMN, wMKV, 512, 1024, 1024}; pg8::StaticOrder S; S.init(512, 1024, G, (bx + 128) % G); EpiF32 E{MKV, 1024};
          pg8::gemm_phase<EpiF32, pg8::StaticOrder, true, true>(lds, g, S, E); }
        if (G == 256 && bx >= 136) {
            LAS float* scr = (LAS float*)(lds + wave * 16384); const int gw2 = (bx - 136) * 8 + wave, ngw2 = 120 * 8;
            transpose_mat(args.in[5], 2816, 1024, nullptr, 0, wDN1, nullptr, scr, gw2, ngw2, lane);
            transpose_mat(args.in[7], 1024, 5280, args.in[6], 2, wIN, wGT, scr, gw2, ngw2, lane, 0, 69);
            transpose_mat(args.in[14], 384, 768, args.in[13], 0, wUQ, nullptr, scr, gw2, ngw2, lane);
            transpose_mat(args.in[16], 256, 1024, args.in[15], 0, wUKV, nullptr, scr, gw2, ngw2, lane);
        }
    }
    SEAM(1);
    if (IN(2)) DUP(2) { unsigned char* ws = opaque_ptr(args.ws); const bool dry = rep_ < ((DUP_MASK >> 2) & 1);
        pg8::Gemm g{ACT, wDN1, T, 1024, FF}; pg8::StaticOrder S; S.init(T, 1024, G, bx); EpiResid<true, true, false> E{(const float*)(ws + S_R0), XB, nullptr, X1B, dry ? (float*)(ws + S_DUMMY) : SS1, 0.5f};
        pg8::gemm_phase<EpiResid<true, true, false>, pg8::StaticOrder, true, true>(lds, g, S, E);
    }
    SEAM(2);
    if (IN(3)) DUP(3) { unsigned char* ws = opaque_ptr(args.ws); const bool dry = rep_ < ((DUP_MASK >> 3) & 1);
        pg8::Gemm g{X1B, wIN, T, NWIN, 1024}; pg8::StaticOrder S; S.init(T, NWIN, G, bx); EpiWin E{SS1, U, VG, CQ, CKV, QM, KR, VST, dry ? (float*)(ws + S_DUMMY) : CQP, dry ? (float*)(ws + S_DUMMY) : CKVP, QMP};
        pg8::gemm_phase<EpiWin, pg8::StaticOrder, true, true>(lds, g, S, E);
        if (G == 256 && bx >= 64) {
            LAS float* scr = (LAS float*)(lds + wave * 16384); const int gw2 = (bx - 64) * 8 + wave, ngw2 = 192 * 8;
            transpose_mat(args.in[7], 1024, 5280, args.in[6], 2, wIN, wGT, scr, gw2, ngw2, lane, 69, 165);
            transpose_mat(args.in[23], 512, 1024, nullptr, 0, wBA, nullptr, scr, gw2, ngw2, lane);
            transpose_mat(args.in[24], 512, 1024, nullptr, 0, wBB, nullptr, scr, gw2, ngw2, lane);
            transpose_mat(args.in[25], 512, 1024, nullptr, 0, wBC, nullptr, scr, gw2, ngw2, lane);
            transpose_mat(args.in[26], 1024, 1024, nullptr, 0, wOUT, nullptr, scr, gw2, ngw2, lane);
            transpose_mat(args.in[28], 1024, 5632, args.in[27], 1, wGU2, nullptr, scr, gw2, ngw2, lane);
            transpose_mat(args.in[29], 2816, 1024, nullptr, 0, wDN2, nullptr, scr, gw2, ngw2, lane);
        }
    }
    SEAM(3);
    if (IN(4)) DUP(4) { unsigned char* ws = opaque_ptr(args.ws); const bool dry = rep_ < ((DUP_MASK >> 4) & 1);
#ifndef NO_UQ
        { int kk = 384; asm volatile("" : "+s"(kk)); pg8::Gemm g{CQ, wUQ, T, 768, kk}; pg8::StaticOrder S; S.init(T, 768, G, bx); EpiUq E{CQP, QRAW};
          pg8::gemm_phase<EpiUq, pg8::StaticOrder, true, true>(lds, g, S, E); }
#endif
#ifndef NO_UKV
        { int kk = 256; asm volatile("" : "+s"(kk)); pg8::Gemm g{CKV, wUKV, T, 1024, kk}; pg8::StaticOrder S; S.init(T, 1024, G, bx); EpiUkv E{CKVP, KN, VT};
          pg8::gemm_phase<EpiUkv, pg8::StaticOrder, true, true>(lds, g, S, E); }
#endif
        __syncthreads();
#ifndef NO_SGU
        if (!dry) { int par = 0; for (int it = bx; it < 1024; it += G, par ^= 1) sgu_item(it >> 7, it & 127, par, wSG, VG, VST, args.in[9], args.in[10], args.in[12], U, lds); __syncthreads(); }
#endif
    }
    SEAM(4);
    if (IN(5)) { unsigned char* ws = opaque_ptr(args.ws);
        {
            constexpr int NB = 4;
            const float* qn = args.in[17]; const float* kn = args.in[18];
            const int m = lane & 15, grp = lane >> 4; const bool act = m < 12, isrope = m >= 8 && m < 12, isx1 = m < 10; const int mm = act ? m : 0, i0 = 8 * (m & 1);
            float gq[8], gk[8], inv[8];
#pragma unroll
            for (int e = 0; e < 8; ++e) { gq[e] = qn[8 * mm + e] * QSCALE_MLA; gk[e] = kn[8 * mm + e]; inv[e] = ROPE_INV[i0 + e]; }
#pragma unroll 1
            for (int it0 = gw * NB; it0 < T * 2; it0 += ngw * NB) {
                u32x4 qa[NB], ka[NB]; f32x4 kb0[NB], kb1[NB]; float pos[NB];
#pragma unroll
                for (int u = 0; u < NB; ++u) {
                    const int task = (it0 + u) * 4 + grp, tok = task >> 3, hd = task & 7;
                    pos[u] = (float)positions[tok];
                    qa[u] = (u32x4){0u, 0u, 0u, 0u}; ka[u] = (u32x4){0u, 0u, 0u, 0u}; kb0[u] = (f32x4){0.f, 0.f, 0.f, 0.f}; kb1[u] = (f32x4){0.f, 0.f, 0.f, 0.f};
                    if (m < 8) ka[u] = *(const u32x4*)(KN + (size_t)tok * 512 + hd * 64 + 8 * m);
                    if (isrope) { kb0[u] = *(const f32x4*)(KR + (size_t)tok * 32 + 8 * (m - 8)); kb1[u] = *(const f32x4*)(KR + (size_t)tok * 32 + 8 * (m - 8) + 4); }
                }
#pragma unroll
                for (int u = 0; u < NB; ++u) {
                    const int task = (it0 + u) * 4 + grp, tok = task >> 3, hd = task & 7;
                    float cs[8], sn[8];
#pragma unroll
                    for (int e = 0; e < 8; ++e) { const float ang = pos[u] * inv[e]; const double rev = (double)ang * 0.15915494309189535; const float f = (float)(rev - floor(rev));
                        cs[e] = __builtin_amdgcn_cosf(f); sn[e] = __builtin_amdgcn_sinf(f); }
                    float v[8];
                    {
                        const u32x4 a = ka[u];
                        if (m < 8) { v[0] = bflo(a.x); v[1] = bfhi(a.x); v[2] = bflo(a.y); v[3] = bfhi(a.y); v[4] = bflo(a.z); v[5] = bfhi(a.z); v[6] = bflo(a.w); v[7] = bfhi(a.w); }
                        else { v[0] = kb0[u][0]; v[1] = kb0[u][1]; v[2] = kb0[u][2]; v[3] = kb0[u][3]; v[4] = kb1[u][0]; v[5] = kb1[u][1]; v[6] = kb1[u][2]; v[7] = kb1[u][3]; }
                        float ss = 0.f;
#pragma unroll
                        for (int e = 0; e < 8; ++e) ss += v[e] * v[e];
                        ss += __shfl_xor(ss, 1); ss += __shfl_xor(ss, 2); ss += __shfl_xor(ss, 4); ss += __shfl_xor(ss, 8);
                        const float rk = __builtin_amdgcn_rsqf(ss * (1.0f / 96.0f) + EPS);
#pragma unroll
                        for (int e = 0; e < 8; ++e) v[e] = v[e] * rk * gk[e];
#pragma unroll
                        for (int e = 0; e < 8; ++e) { const float o = __shfl_xor(v[e], 2); if (isrope) v[e] = isx1 ? v[e] * cs[e] - o * sn[e] : v[e] * cs[e] + o * sn[e]; }
                        if (act) { u32x4 w; w.x = pk2(v[0], v[1]); w.y = pk2(v[2], v[3]); w.z = pk2(v[4], v[5]); w.w = pk2(v[6], v[7]); *(u32x4*)(KF + (size_t)tok * 768 + hd * 96 + 8 * m) = w; }
                    }
                }
            }
        }
        {
            const float* mkn = args.in[22];
            for (int idx = gw; idx < 512 * 4; idx += ngw) {
                const int row = idx >> 2, hd = idx & 3;
                const float a = MKV[(size_t)row * 1024 + hd * 128 + 2 * lane], b = MKV[(size_t)row * 1024 + hd * 128 + 2 * lane + 1];
                const float rk = __builtin_amdgcn_rsqf(wave_sum(a * a + b * b) * (1.0f / 128.0f) + EPS);
                ((unsigned*)(KM + (size_t)row * 512 + hd * 128))[lane] = pk2(a * rk * mkn[2 * lane], b * rk * mkn[2 * lane + 1]);
            }
            for (int i = gt; i < 2 * 4 * 128 * 256; i += ngt) { const int m = i & 255, d = (i >> 8) & 127, hd = (i >> 15) & 3, b = i >> 17;
                VMT[i] = (bf16_t)f2bf(MKV[(size_t)(b * 256 + m) * 1024 + 512 + hd * 128 + d]); }
        }
    }
    SEAM(5);
    if (IN(6)) DUP(6) { unsigned char* ws = opaque_ptr(args.ws);
        const int vcu = (G % 8 == 0) ? (bx % 8) * (G / 8) + bx / 8 : bx;
        float kbound;
        { const float* kng = args.in[18]; float gmx = fabsf(kng[lane]); if (lane < 32) gmx = fmaxf(gmx, fabsf(kng[64 + lane]));
#pragma unroll
          for (int o_ = 1; o_ < 64; o_ <<= 1) gmx = fmaxf(gmx, __shfl_xor(gmx, o_));
          kbound = gmx * 9.797958971f * 1.01f; }
#ifndef NO_MLA
        for (int p = vcu; p < 256; p += G) {
            const int bh = p >> 4, s = p & 15, b = bh >> 3, hd = bh & 7;
#pragma unroll 1
            for (int e = 0; e < 2; ++e) {
                const int qb = e == 0 ? 31 - s : s, q0 = qb * 256;
                attn_unit<96, 64, true, 128, true>(QRAW + ((size_t)(b * SEQ + q0)) * 768 + hd * 96, 768, KF + (size_t)b * SEQ * 768 + hd * 96, 768, VT + (size_t)(b * 8 + hd) * 64 * SEQ, SEQ,
                                        YB + ((size_t)(b * SEQ + q0)) * 512 + hd * 64, 512, q0, (q0 + 256) / 128, lds, kbound, args.in[17], positions + b * SEQ + q0, QSCALE_MLA);
            }
        }
#endif
#ifndef NO_MEMATT
        for (int p = bx; p < 256; p += G) {
            const int qb = p & 31, hd = (p >> 5) & 3, b = p >> 7, q0 = qb * 256;
            attn_unit<128, 128, false, 64, false>(QM + ((size_t)(b * SEQ + q0)) * 512 + hd * 128, 512, KM + (size_t)b * 256 * 512 + hd * 128, 512, VMT + (size_t)(b * 4 + hd) * 128 * 256, 256,
                                       YC + ((size_t)(b * SEQ + q0)) * 512 + hd * 128, 512, q0, 4, lds, 0.f, args.in[21], nullptr, QSCALE_MEM);
        }
#endif
    }
    SEAM(6);
    if (IN(7)) DUP(7) { unsigned char* ws = opaque_ptr(args.ws);
        pg8::Gemm g{X1B, wGT, T, NGATE, 1024}; GateOrder S; S.base.init(T, 1024, G, bx); EpiGate E{SS1, args.in[8], G0};
        pg8::gemm_phase<EpiGate, GateOrder, true, true>(lds, g, S, E);
    }
    if (IN(8)) DUP(8) { unsigned char* ws = opaque_ptr(args.ws);
        static_assert(B_YB - B_U == 16 * MiB && B_YC - B_YB == 16 * MiB && W_BB - W_BA == MiB && W_BC - W_BB == MiB, "branch operands contiguous");
        int kk = 512; asm volatile("" : "+s"(kk));
        pg8::Gemm g{U, wBA, 3 * T, 3072, kk}; BranchOrder S; S.base.init(T, 1024, G, bx); EpiBranch E{G0, MGO};
        pg8::gemm_phase<EpiBranch, BranchOrder, true, true>(lds, g, S, E);
    }
    SEAM(8);
    if (IN(9)) DUP(9) { unsigned char* ws = opaque_ptr(args.ws); const bool dry = rep_ < ((DUP_MASK >> 9) & 1);
        pg8::Gemm g{MGO, wOUT, T, 1024, 1024}; pg8::StaticOrder S; S.init(T, 1024, G, bx); EpiResid<true, true, false> E{nullptr, X1B, nullptr, X2B, dry ? (float*)(ws + S_DUMMY) : SS2, 1.0f};
        pg8::gemm_phase<EpiResid<true, true, false>, pg8::StaticOrder, true, true>(lds, g, S, E);
    }
    SEAM(9);
    if (IN(10)) DUP(10) { unsigned char* ws = opaque_ptr(args.ws);
        pg8::Gemm g{X2B, wGU2, T, 5632, 1024}; pg8::StaticOrder S; S.init(T, 5632, G, bx); EpiSwiglu<16> E{ACT, SS2};
        pg8::gemm_phase<EpiSwiglu<16>, pg8::StaticOrder, true, true>(lds, g, S, E);
    }
    SEAM(10);
    if (IN(11)) DUP(11) { unsigned char* ws = opaque_ptr(args.ws); const bool dry = rep_ < ((DUP_MASK >> 11) & 1);
        pg8::Gemm g{ACT, wDN2, T, 1024, FF}; pg8::StaticOrder S; S.init(T, 1024, G, bx); EpiResid<false, true, true> E{nullptr, X2B, out, nullptr, nullptr, 0.5f};
        pg8::gemm_phase<EpiResid<false, true, true>, pg8::StaticOrder, true, true>(lds, g, S, E);
    }
#undef IN
#undef SEAM
}

#ifndef N_LAUNCH_SPLIT
#define N_LAUNCH_SPLIT 0
#endif
extern "C" void kernel_launch(void* const* d_in, const int* in_sizes, int n_in, void* d_out, int out_size, void* d_ws, size_t ws_size, hipStream_t stream) {
    static int grid = 0;
    if (grid == 0) {
        if (n_in != 30 || out_size != T * DM || ws_size < WS_NEED) { fprintf(stderr, "kernel_launch: unexpected shapes (n_in %d out %d ws %zu)\n", n_in, out_size, ws_size); grid = -1; return; }
        int dev = 0, cus = 0, per_cu = 0;
        hipGetDevice(&dev); hipDeviceGetAttribute(&cus, hipDeviceAttributeMultiprocessorCount, dev);
        if (hipFuncSetAttribute((const void*)fwd_mega, hipFuncAttributeMaxDynamicSharedMemorySize, LDS_BYTES) != hipSuccess) { fprintf(stderr, "kernel_launch: hipFuncSetAttribute failed\n"); grid = -1; return; }
        if (hipOccupancyMaxActiveBlocksPerMultiprocessor(&per_cu, (const void*)fwd_mega, 512, LDS_BYTES) != hipSuccess || per_cu < 1) { fprintf(stderr, "kernel_launch: occupancy query says %d\n", per_cu); per_cu = 1; }
        (void)hipGetLastError();
        grid = cus * 1;
        if (grid > cus * per_cu) grid = cus * per_cu;
    }
    if (grid < 0) return;
    if (hipMemsetAsync((char*)d_ws + S_BAR, 0, XCD_BAR_WORDS * 4, stream) != hipSuccess) { fprintf(stderr, "kernel_launch: hipMemsetAsync of the barrier words failed\n"); return; }
    Args a{};
    for (int i = 0; i < 30; ++i) a.in[i] = (const float*)d_in[i];
    a.out = (float*)d_out; a.ws = (unsigned char*)d_ws;
#if N_LAUNCH_SPLIT
    for (int p = 0; p < NPH; ++p) { a.ph_lo = p; a.ph_hi = p + 1; void* kargs[] = {&a}; hipError_t e = hipLaunchCooperativeKernel((const void*)fwd_mega, dim3(grid), dim3(512), kargs, LDS_BYTES, stream);
        if (e != hipSuccess) { fprintf(stderr, "launch %d failed: %s\n", p, hipGetErrorString(e)); break; } }
#else
    a.ph_lo = 0; a.ph_hi = NPH; void* kargs[] = {&a};
    hipError_t e = hipLaunchCooperativeKernel((const void*)fwd_mega, dim3(grid), dim3(512), kargs, LDS_BYTES, stream);
    if (e != hipSuccess) fprintf(stderr, "cooperative launch failed: %s (grid %d)\n", hipGetErrorString(e), grid);
#endif
}
```

```cpp
#include <hip/hip_runtime.h>
#include <hip/hip_cooperative_groups.h>
#include <cstdio>
#include <cstdint>
namespace cg = cooperative_groups;
namespace pg8 {
#define PG8_LAS __attribute__((address_space(3)))
typedef unsigned short bf16_t;
typedef short bf16x8 __attribute__((ext_vector_type(8)));
typedef float f32x4 __attribute__((ext_vector_type(4)));
typedef unsigned u32x4 __attribute__((ext_vector_type(4)));
constexpr int BM = 256, BK = 64, HALF = 128, HTB = HALF * BK * 2  , STAGE_BYTES = 8 * HTB, NXCD = 8, WGM = 8;

__host__ __device__ __forceinline__ int lds_byte(int r, int c) { const int st = (r >> 4) * 2 + (c >> 5), rr = r & 15, cc = c & 31, ob = rr * 64 + cc * 2; return st * 1024 + (ob ^ (((ob >> 9) & 1) << 5)); }
__host__ __device__ __forceinline__ void stage_rc(int b, int& R, int& C) { const int st = b / 1024, sb = b % 1024, swz = sb ^ (((sb >> 9) & 1) << 5); R = (st >> 1) * 16 + swz / 64; C = (st & 1) * 32 + (swz % 64) / 2; }
__host__ __device__ __forceinline__ int perm32(int rho) { const int n = rho >> 4, i = rho & 15; return 8 * (i >> 2) + 4 * n + (i & 3); }

struct Unit { int pm, pn; };
struct Gemm { const bf16_t* A; const bf16_t* Bt; int M, N, K; };

struct StaticOrder {
    int nM, nN, nwg, G, c;
    __host__ __device__ void init(int M, int N, int G_, int c_) { nM = M / BM; nN = N / BM; nwg = nM * nN; G = G_; c = c_; }
    __host__ __device__ bool next(int i, Unit& u) const {
        const long L = (long)i * G + c; if (L >= nwg) return false;
        int wgid = (int)L; { const int q = nwg / NXCD, r = nwg % NXCD, xcd = wgid % NXCD, off = wgid / NXCD; wgid = (xcd < r ? xcd * (q + 1) : r * (q + 1) + (xcd - r) * q) + off; }
        const int nig = WGM * nN, gid = wgid / nig, fm = gid * WGM, gsz = (nM - fm) < WGM ? (nM - fm) : WGM;
        u.pm = fm + ((wgid % nig) % gsz); u.pn = (wgid % nig) / gsz; return true;
    }
    __device__ __forceinline__ void a_ready(const Unit&) const {}
    __device__ __forceinline__ void done(const Unit&) const {}
};
__device__ __forceinline__ unsigned cvt_pk_bf16(float lo, float hi) { unsigned r; asm volatile("v_cvt_pk_bf16_f32 %0, %1, %2" : "=v"(r) : "v"(lo), "v"(hi)); return r; }
typedef float f32x2 __attribute__((ext_vector_type(2)));
__device__ __forceinline__ f32x2 gelu_pk(f32x2 v) {
    const f32x2 av = __builtin_elementwise_abs(v), d = av * 0.2316418882f + 1.0f;
    f32x2 t; t.x = __builtin_amdgcn_rcpf(d.x); t.y = __builtin_amdgcn_rcpf(d.y);
    f32x2 q = t * 0.5307027145f + (-0.7265760135f); q = q * t + 0.7107068705f; q = q * t + (-0.142248368f); q = q * t + 0.127414796f; q = q * t;
    const f32x2 s = (v * v) * (-0.72134752044f);
    f32x2 e; e.x = __builtin_amdgcn_exp2f(s.x); e.y = __builtin_amdgcn_exp2f(s.y);
    const f32x2 m = v * (q * e), r = v - m;
    f32x2 o; o.x = v.x < 0.f ? m.x : r.x; o.y = v.y < 0.f ? m.y : r.y; return o;
}
template <class Epi, class Sched, bool ALIGN_EPI = false, bool SP2 = false>
__device__ __forceinline__ void gemm_phase(PG8_LAS unsigned char* lds, const Gemm g, const Sched& S, const Epi& E) {
    const int tid = threadIdx.x, wid = __builtin_amdgcn_readfirstlane(tid >> 6), lane = tid & 63, wr = wid >> 2, wc = wid & 3, fr = lane & 15, fq = lane >> 4;
    const int K = g.K, nt = K / BK;
    unsigned voffA[2], voffB[2];
#pragma unroll
    for (int i = 0; i < 2; ++i) { int R, C; stage_rc(tid * 16 + i * 8192, R, C); const int Rb = Epi::PERM ? ((R & ~31) + perm32(R & 31)) : R;
        voffA[i] = (unsigned)(R * K + C) * 2u; voffB[i] = (unsigned)(Rb * K + C) * 2u; }
    const size_t kstep = (size_t)(BK * 2);
    const size_t hstep = (size_t)HALF * K * 2;
    const size_t tstep = 2 * hstep;
    const unsigned ldsw = (unsigned)wid * 1024u;
    const int aoff = lds_byte(wr * 64 + fr, fq * 8), boff = lds_byte(wc * 32 + fr, fq * 8);
#define PG8_SA(b, h) (((b) * 2 + (h)) * HTB)
#define PG8_SB(b, h) ((4 + (b) * 2 + (h)) * HTB)
#define PG8_STAGE(bufoff, gbase, voff) do { _Pragma("unroll") for (int _i = 0; _i < 2; ++_i) \
        __builtin_amdgcn_global_load_lds((const unsigned*)((const char*)(gbase) + (voff)[_i]), (PG8_LAS unsigned*)(lds + (bufoff) + ldsw + _i * 8192), 16, 0, 0); } while (0)
#define PG8_LDA(dst, b, h) do { _Pragma("unroll") for (int m = 0; m < 4; ++m) _Pragma("unroll") for (int k = 0; k < 2; ++k) dst[m][k] = *(const PG8_LAS bf16x8*)(lds + PG8_SA(b, h) + aoff + m * 2048 + k * 1024); } while (0)
#define PG8_LDB(dst, b, h) do { _Pragma("unroll") for (int n = 0; n < 2; ++n) _Pragma("unroll") for (int k = 0; k < 2; ++k) dst[n][k] = *(const PG8_LAS bf16x8*)(lds + PG8_SB(b, h) + boff + n * 2048 + k * 1024); } while (0)
#define PG8_MMA(ai, bj, At, Bt) do { __builtin_amdgcn_s_setprio(1); _Pragma("unroll") for (int m = 0; m < 4; ++m) _Pragma("unroll") for (int n = 0; n < 2; ++n) _Pragma("unroll") for (int k = 0; k < 2; ++k) \
        acc[ai][bj][m][n] = __builtin_amdgcn_mfma_f32_16x16x32_bf16(Bt[n][k], At[m][k], acc[ai][bj][m][n], 0, 0, 0); __builtin_amdgcn_s_setprio(0); } while (0)
#define PG8_WAIT_V(n) asm volatile("s_waitcnt vmcnt(" #n ")" ::: "memory")
#define PG8_WAIT_L(n) asm volatile("s_waitcnt lgkmcnt(" #n ")" ::: "memory")
#define PG8_BAR __builtin_amdgcn_s_barrier()
#define PG8_SCHED __builtin_amdgcn_sched_barrier(0)
    Unit cur, nxt; int ui = 0;
    if (!S.next(0, cur)) return;
    f32x4 acc[2][2][4][2];
#pragma unroll
    for (int a = 0; a < 2; ++a)
#pragma unroll
        for (int b = 0; b < 2; ++b)
#pragma unroll
            for (int m = 0; m < 4; ++m)
#pragma unroll
                for (int n = 0; n < 2; ++n) acc[a][b][m][n] = (f32x4){0.f, 0.f, 0.f, 0.f};
    bf16x8 At[4][2], B0[2][2], B1[2][2];
    const char* cA = (const char*)g.A + (size_t)cur.pm * tstep; const char* cB = (const char*)g.Bt + (size_t)cur.pn * tstep;
    S.a_ready(cur);
    if constexpr (SP2) {
        PG8_STAGE(PG8_SB(0, 0), cB, voffB); PG8_STAGE(PG8_SB(0, 1), cB + hstep, voffB); PG8_STAGE(PG8_SA(0, 0), cA, voffA); PG8_STAGE(PG8_SA(0, 1), cA + hstep, voffA);
        if (wr == 1) PG8_BAR;
        PG8_WAIT_V(2); PG8_BAR;
        PG8_STAGE(PG8_SB(1, 0), cB + kstep, voffB); PG8_STAGE(PG8_SA(1, 0), cA + kstep, voffA); PG8_STAGE(PG8_SB(1, 1), cB + hstep + kstep, voffB);
        PG8_WAIT_V(6); PG8_BAR;
    } else {
        PG8_STAGE(PG8_SB(0, 0), cB, voffB); PG8_STAGE(PG8_SA(0, 0), cA, voffA); PG8_STAGE(PG8_SB(0, 1), cB + hstep, voffB); PG8_STAGE(PG8_SA(0, 1), cA + hstep, voffA);
        if (wr == 1) PG8_BAR;
        PG8_WAIT_V(4); PG8_BAR;
        PG8_STAGE(PG8_SB(1, 0), cB + kstep, voffB); PG8_STAGE(PG8_SA(1, 0), cA + kstep, voffA); PG8_STAGE(PG8_SB(1, 1), cB + hstep + kstep, voffB);
        PG8_WAIT_V(6); PG8_BAR;
    }
    for (;;) {
        const bool has_next = S.next(ui + 1, nxt);
        const char* nA = has_next ? (const char*)g.A + (size_t)nxt.pm * tstep : cA; const char* nB = has_next ? (const char*)g.Bt + (size_t)nxt.pn * tstep : cB;
        for (int t = 0; t < nt; t += 2) {
            const bool last = (t == nt - 2);
            const char* a1 = cA + (size_t)(t + 1) * kstep;
            const char* a2 = last ? nA : cA + (size_t)(t + 2) * kstep; const char* b2 = last ? nB : cB + (size_t)(t + 2) * kstep;
            const char* a3 = a2 + kstep; const char* b3 = b2 + kstep;
            if (last && has_next) S.a_ready(nxt);
            if constexpr (SP2) {
            PG8_LDB(B0, 0, 0); PG8_LDB(B1, 0, 1); PG8_SCHED; PG8_LDA(At, 0, 0); PG8_STAGE(PG8_SA(1, 1), a1 + hstep, voffA);
            PG8_WAIT_V(8); PG8_WAIT_L(0); PG8_BAR; PG8_MMA(0, 0, At, B0); PG8_MMA(0, 1, At, B1); PG8_BAR; PG8_SCHED;
            PG8_LDA(At, 0, 1); PG8_STAGE(PG8_SB(0, 0), b2, voffB); PG8_STAGE(PG8_SB(0, 1), b2 + hstep, voffB); PG8_STAGE(PG8_SA(0, 0), a2, voffA);
            PG8_WAIT_V(8); PG8_WAIT_L(0); PG8_BAR; PG8_MMA(1, 0, At, B0); PG8_MMA(1, 1, At, B1); PG8_BAR; PG8_SCHED;
            PG8_LDB(B0, 1, 0); PG8_LDB(B1, 1, 1); PG8_SCHED; PG8_LDA(At, 1, 0); PG8_STAGE(PG8_SA(0, 1), a2 + hstep, voffA);
            PG8_WAIT_V(8); PG8_WAIT_L(0); PG8_BAR; PG8_MMA(0, 0, At, B0); PG8_MMA(0, 1, At, B1); PG8_BAR; PG8_SCHED;
            PG8_LDA(At, 1, 1); PG8_STAGE(PG8_SB(1, 0), b3, voffB); PG8_STAGE(PG8_SB(1, 1), b3 + hstep, voffB); PG8_STAGE(PG8_SA(1, 0), a3, voffA);
            PG8_WAIT_V(8); PG8_WAIT_L(0); PG8_BAR; PG8_MMA(1, 0, At, B0); PG8_MMA(1, 1, At, B1); PG8_BAR; PG8_SCHED;
            } else {
            PG8_LDB(B0, 0, 0); PG8_SCHED; PG8_LDA(At, 0, 0); PG8_STAGE(PG8_SA(1, 1), a1 + hstep, voffA);
            PG8_WAIT_L(8); PG8_BAR; PG8_WAIT_L(0); PG8_MMA(0, 0, At, B0); PG8_BAR; PG8_SCHED;
            PG8_LDB(B1, 0, 1); PG8_STAGE(PG8_SB(0, 0), b2, voffB);
            PG8_BAR; PG8_WAIT_L(0); PG8_MMA(0, 1, At, B1); PG8_BAR;
            PG8_LDA(At, 0, 1); PG8_STAGE(PG8_SA(0, 0), a2, voffA);
            PG8_BAR; PG8_WAIT_L(0); PG8_MMA(1, 0, At, B0); PG8_BAR; PG8_SCHED;
            PG8_STAGE(PG8_SB(0, 1), b2 + hstep, voffB);
            PG8_WAIT_V(6); PG8_BAR; PG8_MMA(1, 1, At, B1); PG8_BAR;
            PG8_LDB(B0, 1, 0); PG8_SCHED; PG8_LDA(At, 1, 0); PG8_STAGE(PG8_SA(0, 1), a2 + hstep, voffA);
            PG8_WAIT_L(8); PG8_BAR; PG8_WAIT_L(0); PG8_MMA(0, 0, At, B0); PG8_BAR; PG8_SCHED;
            PG8_LDB(B1, 1, 1); PG8_STAGE(PG8_SB(1, 0), b3, voffB);
            PG8_BAR; PG8_WAIT_L(0); PG8_MMA(0, 1, At, B1); PG8_BAR;
            PG8_LDA(At, 1, 1); PG8_STAGE(PG8_SA(1, 0), a3, voffA);
            PG8_BAR; PG8_WAIT_L(0); PG8_MMA(1, 0, At, B0); PG8_BAR; PG8_SCHED;
            PG8_STAGE(PG8_SB(1, 1), b3 + hstep, voffB);
            PG8_WAIT_V(6); PG8_BAR; PG8_MMA(1, 1, At, B1); PG8_BAR;
            }
        }
        if constexpr (ALIGN_EPI) { if (wr == 0) PG8_BAR; }
        if constexpr (!Epi::AFTER_DRAIN) { E(acc, cur, wr, wc, fr, fq); S.done(cur); }
        if (!has_next) break;
#pragma unroll
        for (int a = 0; a < 2; ++a)
#pragma unroll
            for (int b = 0; b < 2; ++b)
#pragma unroll
                for (int m = 0; m < 4; ++m)
#pragma unroll
                    for (int n = 0; n < 2; ++n) acc[a][b][m][n] = (f32x4){0.f, 0.f, 0.f, 0.f};
        cur = nxt; cA = nA; cB = nB; ++ui;
        if constexpr (ALIGN_EPI) { if (wr == 1) PG8_BAR; }
    }
    PG8_WAIT_V(0);
    if constexpr (!ALIGN_EPI) { if (wr == 0) PG8_BAR; }
    PG8_BAR;
    if constexpr (Epi::AFTER_DRAIN) { E.fused(acc, cur, wr, wc, fr, fq, lds, wid, lane); S.done(cur); }
#undef PG8_SA
#undef PG8_SB
#undef PG8_STAGE
#undef PG8_LDA
#undef PG8_LDB
#undef PG8_MMA
#undef PG8_WAIT_V
#undef PG8_WAIT_L
#undef PG8_BAR
#undef PG8_SCHED
}
}

#define DI __device__ __forceinline__
#define LAS __attribute__((address_space(3)))
using pg8::bf16_t; using pg8::f32x4; using pg8::bf16x8; using pg8::u32x4; using pg8::Unit; using pg8::f32x2;
typedef float f32x16 __attribute__((ext_vector_type(16)));
typedef short s16x4 __attribute__((ext_vector_type(4)));
typedef unsigned u32x2 __attribute__((ext_vector_type(2)));

constexpr int T = 16384, SEQ = 8192, DM = 1024, FF = 2816;
constexpr int NWIN = 2304, NGATE = 3072;
constexpr float EPS = 1e-6f;
constexpr float LOG2E = 1.4426950408889634f;
constexpr float QSCALE_MLA = 0.10206207261596575f * LOG2E;
constexpr float QSCALE_MEM = 0.08838834764831845f * LOG2E;

constexpr size_t MiB = 1u << 20;
constexpr size_t W_GU1 = 0, W_DN1 = 11 * MiB, W_IN = W_DN1 + 5632 * 1024, W_GT = W_IN + (size_t)NWIN * 2048, W_UQ = 27 * MiB + 512 * 1024, W_UKV = 28 * MiB + 512 * 1024,
                 W_MKV = 29 * MiB, W_BA = 31 * MiB, W_BB = 32 * MiB, W_BC = 33 * MiB, W_OUT = 34 * MiB, W_GU2 = 36 * MiB, W_DN2 = 47 * MiB, W_SG = 53 * MiB;
static_assert(W_GT + (size_t)NGATE * 2048 <= W_UQ && W_UQ + 768 * 384 * 2 <= W_UKV && W_DN2 + 5632 * 1024 <= W_SG, "weight map");
constexpr size_t S_SS1 = 54 * MiB, S_SS2 = 55 * MiB, S_VST = 56 * MiB, S_CQP = 58 * MiB, S_CKVP = 59 * MiB, S_QMP = 60 * MiB, S_KR = 61 * MiB,
                 S_MEMN = 63 * MiB, S_MKV = 64 * MiB, S_KM = 66 * MiB, S_VMT = 66 * MiB + 512 * 1024;
constexpr size_t S_BAR = 53 * MiB + 512 * 1024;
constexpr size_t S_R0 = 53 * MiB + 384 * 1024;
constexpr size_t S_DUMMY = 53 * MiB + 256 * 1024;
constexpr size_t BIG = 67 * MiB;
constexpr size_t B_X1B = BIG, B_MG = BIG, B_U = BIG + 32 * MiB, B_YB = BIG + 48 * MiB, B_YC = BIG + 64 * MiB, B_VG = BIG + 48 * MiB, B_CQ = BIG + 64 * MiB, B_CKV = BIG + 76 * MiB,
                 B_QM = BIG + 84 * MiB, B_QRAW = BIG + 100 * MiB, B_K = BIG + 124 * MiB, B_VT = BIG + 148 * MiB, B_KN = BIG + 164 * MiB,
                 B_G0 = BIG + 80 * MiB, B_G1 = BIG + 112 * MiB, B_G2 = BIG + 144 * MiB, B_ACT = BIG + 32 * MiB, B_XB = BIG + 120 * MiB, B_X2B = BIG + 120 * MiB;
static_assert(B_G1 - B_G0 == 32 * MiB && B_G2 - B_G1 == 32 * MiB, "gate buffers 32 MiB apart");
constexpr size_t WS_NEED = BIG + 184 * MiB;

DI unsigned f2bf(float f) { unsigned u = __builtin_bit_cast(unsigned, f); return (u + 0x7fffu + ((u >> 16) & 1u)) >> 16; }
DI unsigned pk2(float lo, float hi) { typedef float v2f __attribute__((ext_vector_type(2))); typedef __bf16 v2b __attribute__((ext_vector_type(2))); v2f v = {lo, hi}; v2b b = __builtin_convertvector(v, v2b); return __builtin_bit_cast(unsigned, b); }
DI float bflo(unsigned w) { return __uint_as_float(w << 16); }
DI float bfhi(unsigned w) { return __uint_as_float(w & 0xffff0000u); }
DI float sigmoidf_(float v) { return __builtin_amdgcn_rcpf(1.0f + __expf(-v)); }
DI float siluf_(float v) { return v * sigmoidf_(v); }

template <int NP> DI float row_rstd(const float* P, int row, float invn) {
    if (NP == 0) return 1.0f;
    return __builtin_amdgcn_rsqf(P[row] * invn + EPS);
}
DI void atomic_addf(float* p, float v) { __builtin_amdgcn_global_atomic_fadd_f32((__attribute__((address_space(1))) float*)p, v); }
DI float quad_sum(float s) { s += __shfl_xor(s, 16); s += __shfl_xor(s, 32); return s; }

template <int NP> struct EpiSwiglu {
    static constexpr bool PERM = true, AFTER_DRAIN = false;
    bf16_t* O; const float* P;
    DI void operator()(const f32x4 (&acc)[2][2][4][2], const Unit& u, int wr, int wc, int fr, int fq) const {
        const int row0 = u.pm * 256 + wr * 64 + fr, col0 = u.pn * 128 + wc * 32 + 8 * fq;
#pragma unroll
        for (int ai = 0; ai < 2; ++ai)
#pragma unroll
            for (int m = 0; m < 4; ++m) {
                const int row = row0 + ai * 128 + m * 16; const float rs = row_rstd<NP>(P, row, 1.0f / 1024.0f);
                float a[8];
#pragma unroll
                for (int n = 0; n < 2; ++n)
#pragma unroll
                    for (int i = 0; i < 4; ++i) { const float g = acc[ai][0][m][n][i] * rs, uu = acc[ai][1][m][n][i] * rs; a[4 * n + i] = siluf_(g) * uu; }
                u32x4 w; w.x = pk2(a[0], a[1]); w.y = pk2(a[2], a[3]); w.z = pk2(a[4], a[5]); w.w = pk2(a[6], a[7]);
                *(u32x4*)(O + (size_t)row * FF + col0) = w;
            }
    }
};
template <bool WB, bool B16, bool WOUT> struct EpiResid {
    static constexpr bool PERM = true, AFTER_DRAIN = false;
    const float* base  ; const bf16_t* base16; float* out; bf16_t* xb; float* P; float alpha;
    DI void operator()(const f32x4 (&acc)[2][2][4][2], const Unit& u, int wr, int wc, int fr, int fq) const {
        const int row0 = u.pm * 256 + wr * 64 + fr, col0 = u.pn * 256 + wc * 32 + 8 * fq;
#pragma unroll
        for (int ai = 0; ai < 2; ++ai)
#pragma unroll
            for (int m = 0; m < 4; ++m) {
                const int row = row0 + ai * 128 + m * 16; float ss = 0.f;
                const float bs = (B16 && base) ? base[row] : 1.0f;
#pragma unroll
                for (int bj = 0; bj < 2; ++bj) {
                    const size_t off = (size_t)row * DM + col0 + bj * 128;
                    f32x4 b0, b1;
                    if (B16) { const u32x4 bb = *(const u32x4*)(base16 + off); b0 = (f32x4){bflo(bb.x), bfhi(bb.x), bflo(bb.y), bfhi(bb.y)}; b1 = (f32x4){bflo(bb.z), bfhi(bb.z), bflo(bb.w), bfhi(bb.w)}; b0 = b0 * bs; b1 = b1 * bs; }
                    else { b0 = *(const f32x4*)(base + off); b1 = *(const f32x4*)(base + off + 4); }
                    const f32x4 o0 = b0 + acc[ai][bj][m][0] * alpha, o1 = b1 + acc[ai][bj][m][1] * alpha;
                    if (WOUT) { *(f32x4*)(out + off) = o0; *(f32x4*)(out + off + 4) = o1; }
                    if (WB) { ss += (o0[0] * o0[0] + o0[1] * o0[1]) + (o0[2] * o0[2] + o0[3] * o0[3]) + (o1[0] * o1[0] + o1[1] * o1[1]) + (o1[2] * o1[2] + o1[3] * o1[3]);
                        u32x4 w; w.x = pk2(o0[0], o0[1]); w.y = pk2(o0[2], o0[3]); w.z = pk2(o1[0], o1[1]); w.w = pk2(o1[2], o1[3]); *(u32x4*)(xb + off) = w; }
                }
                if (WB) { ss = quad_sum(ss); if (fq == 0) atomic_addf(P + row, ss); }
            }
    }
};
struct EpiWin {
    static constexpr bool PERM = true, AFTER_DRAIN = false;
    const float* P; bf16_t *U, *Vg, *CQ, *CKV, *QM; float *KR, *VST, *CQP, *CKVP, *QMP;
    DI void operator()(const f32x4 (&acc)[2][2][4][2], const Unit& u, int wr, int wc, int fr, int fq) const {
        const int row0 = u.pm * 256 + wr * 64 + fr, cw = wc * 32 + 8 * fq;
#pragma unroll
        for (int ai = 0; ai < 2; ++ai)
#pragma unroll
            for (int m = 0; m < 4; ++m) {
                const int row = row0 + ai * 128 + m * 16; const float rs = row_rstd<16>(P, row, 1.0f / 1024.0f);
#pragma unroll
                for (int bj = 0; bj < 2; ++bj) {
                    const int c128 = u.pn * 256 + bj * 128;
                    float v[8];
#pragma unroll
                    for (int n = 0; n < 2; ++n)
#pragma unroll
                        for (int i = 0; i < 4; ++i) v[4 * n + i] = acc[ai][bj][m][n][i] * rs;
                    if (c128 < 1024) {
#pragma unroll
                        for (int i = 0; i < 8; i += 2) { const f32x2 g = pg8::gelu_pk((f32x2){v[i], v[i + 1]}); v[i] = g.x; v[i + 1] = g.y; }
                        const bool isv = c128 >= 512;
                        u32x4 w; w.x = pk2(v[0], v[1]); w.y = pk2(v[2], v[3]); w.z = pk2(v[4], v[5]); w.w = pk2(v[6], v[7]);
                        *(u32x4*)((isv ? Vg : U) + (size_t)row * 512 + (c128 & 511) + cw) = w;
                        if (isv) {
                            float s1 = 0.f, s2 = 0.f;
#pragma unroll
                            for (int i = 0; i < 8; ++i) { s1 += v[i]; s2 += v[i] * v[i]; }
                            s1 = quad_sum(s1); s2 = quad_sum(s2);
                            if (fq == 0) { float* d = VST + ((size_t)row * 16 + ((c128 - 512) >> 7) * 4 + wc) * 2; d[0] = s1; d[1] = s2; }
                        }
                    } else if (c128 < 2176) {
                        bf16_t* dst; float* pp; const bool isqm = c128 >= 1664;
                        if (c128 < 1408) { dst = CQ + (size_t)row * 384 + (c128 - 1024); pp = CQP + row; }
                        else if (c128 < 1664) { dst = CKV + (size_t)row * 256 + (c128 - 1408); pp = CKVP + row; }
                        else { dst = QM + (size_t)row * 512 + (c128 - 1664); pp = QMP + (size_t)row * 16 + ((c128 - 1664) >> 7) * 4 + wc; }
                        u32x4 w; w.x = pk2(v[0], v[1]); w.y = pk2(v[2], v[3]); w.z = pk2(v[4], v[5]); w.w = pk2(v[6], v[7]);
                        *(u32x4*)(dst + cw) = w;
                        float s2 = 0.f;
#pragma unroll
                        for (int i = 0; i < 8; ++i) s2 += v[i] * v[i];
                        s2 = quad_sum(s2);
                        if (fq == 0) { if (isqm) *pp = s2; else atomic_addf(pp, s2); }
                    } else if (c128 == 2176) {
                        if (wc == 0) { float* d = KR + (size_t)row * 32 + 8 * fq; *(f32x4*)d = (f32x4){v[0], v[1], v[2], v[3]}; *(f32x4*)(d + 4) = (f32x4){v[4], v[5], v[6], v[7]}; }
                    }
                }
            }
    }
};
struct EpiGate {
    static constexpr bool PERM = true, AFTER_DRAIN = false;
    const float* P; const float* bias; bf16_t* G0;
    DI void operator()(const f32x4 (&acc)[2][2][4][2], const Unit& u, int wr, int wc, int fr, int fq) const {
        const int row0 = u.pm * 256 + wr * 64 + fr, br = u.pn >> 2, cw = (u.pn & 3) * 256 + wc * 32 + 8 * fq;
        bf16_t* G = G0 + (size_t)br * (16u << 20);
        f32x4 bv[2][2];
#pragma unroll
        for (int bj = 0; bj < 2; ++bj)
#pragma unroll
            for (int n = 0; n < 2; ++n) bv[bj][n] = *(const f32x4*)(bias + br * 1024 + cw + bj * 128 + 4 * n);
#pragma unroll
        for (int ai = 0; ai < 2; ++ai)
#pragma unroll
            for (int m = 0; m < 4; ++m) {
                const int row = row0 + ai * 128 + m * 16; const float rs = row_rstd<16>(P, row, 1.0f / 1024.0f);
#pragma unroll
                for (int bj = 0; bj < 2; ++bj) {
                    float v[8];
#pragma unroll
                    for (int n = 0; n < 2; ++n)
#pragma unroll
                        for (int i = 0; i < 4; ++i) v[4 * n + i] = sigmoidf_(acc[ai][bj][m][n][i] * rs + bv[bj][n][i]);
                    u32x4 w; w.x = pk2(v[0], v[1]); w.y = pk2(v[2], v[3]); w.z = pk2(v[4], v[5]); w.w = pk2(v[6], v[7]);
                    *(u32x4*)(G + (size_t)row * DM + cw + bj * 128) = w;
                }
            }
    }
};
struct EpiUq {
    static constexpr bool PERM = true, AFTER_DRAIN = false;
    const float* P; bf16_t* O;
    DI void operator()(const f32x4 (&acc)[2][2][4][2], const Unit& u, int wr, int wc, int fr, int fq) const {
        const int row0 = u.pm * 256 + wr * 64 + fr, cw = u.pn * 256 + wc * 32 + 8 * fq;
#pragma unroll
        for (int ai = 0; ai < 2; ++ai)
#pragma unroll
            for (int m = 0; m < 4; ++m) {
                const int row = row0 + ai * 128 + m * 16; const float rs = row_rstd<1>(P, row, 1.0f / 384.0f);
#pragma unroll
                for (int bj = 0; bj < 2; ++bj) {
                    const f32x4 a = acc[ai][bj][m][0] * rs, b = acc[ai][bj][m][1] * rs;
                    u32x4 w; w.x = pk2(a[0], a[1]); w.y = pk2(a[2], a[3]); w.z = pk2(b[0], b[1]); w.w = pk2(b[2], b[3]);
                    *(u32x4*)(O + (size_t)row * 768 + cw + bj * 128) = w;
                }
            }
    }
};
struct EpiUkv {
    static constexpr bool PERM = true, AFTER_DRAIN = false;
    const float* P; bf16_t* KN; bf16_t* Vt;
    DI void operator()(const f32x4 (&acc)[2][2][4][2], const Unit& u, int wr, int wc, int fr, int fq) const {
        const int row0 = u.pm * 256 + wr * 64 + fr;
#pragma unroll
        for (int ai = 0; ai < 2; ++ai)
#pragma unroll
            for (int m = 0; m < 4; ++m) {
                const int row = row0 + ai * 128 + m * 16; const float rs = row_rstd<1>(P, row, 1.0f / 256.0f);
                const int b = row >> 13, s = row & 8191;
#pragma unroll
                for (int bj = 0; bj < 2; ++bj) {
                    const int h = u.pn * 2 + bj;
                    const f32x4 a = acc[ai][bj][m][0] * rs, c = acc[ai][bj][m][1] * rs;
                    if (wc < 2) {
                        u32x4 w; w.x = pk2(a[0], a[1]); w.y = pk2(a[2], a[3]); w.z = pk2(c[0], c[1]); w.w = pk2(c[2], c[3]);
                        *(u32x4*)(KN + (size_t)row * 512 + h * 64 + wc * 32 + 8 * fq) = w;
                    } else {
                        const unsigned vo = (unsigned)((b * 8 + h) * 64 + (wc - 2) * 32 + 8 * fq) * (unsigned)SEQ + (unsigned)s;
#pragma unroll
                        for (int i = 0; i < 4; ++i) { Vt[vo + (unsigned)(i * SEQ)] = (bf16_t)f2bf(a[i]); Vt[vo + (unsigned)((4 + i) * SEQ)] = (bf16_t)f2bf(c[i]); }
                    }
                }
            }
    }
};
struct EpiF32 {
    static constexpr bool PERM = true, AFTER_DRAIN = false;
    float* O; int ldc;
    DI void operator()(const f32x4 (&acc)[2][2][4][2], const Unit& u, int wr, int wc, int fr, int fq) const {
        const int row0 = u.pm * 256 + wr * 64 + fr, col0 = u.pn * 256 + wc * 32 + 8 * fq;
#pragma unroll
        for (int ai = 0; ai < 2; ++ai)
#pragma unroll
            for (int m = 0; m < 4; ++m)
#pragma unroll
                for (int bj = 0; bj < 2; ++bj)
#pragma unroll
                    for (int n = 0; n < 2; ++n) *(f32x4*)(O + (size_t)(row0 + ai * 128 + m * 16) * ldc + col0 + bj * 128 + n * 4) = acc[ai][bj][m][n];
    }
};
struct GateOrder {
    pg8::StaticOrder base;
    __device__ bool next(int i, Unit& u) const { Unit b; if (!base.next(i / 3, b)) return false; u.pm = b.pm; u.pn = b.pn + 4 * (i % 3); return true; }
    DI void a_ready(const Unit&) const {}
    DI void done(const Unit&) const {}
};
struct BranchOrder {
    pg8::StaticOrder base;
    __device__ bool next(int i, Unit& u) const { Unit b; if (!base.next(i / 3, b)) return false; const int br = i % 3; u.pm = b.pm + 64 * br; u.pn = b.pn + 4 * br; return true; }
    DI void a_ready(const Unit&) const {}
    DI void done(const Unit&) const {}
};
struct EpiBranch {
    static constexpr bool PERM = true, AFTER_DRAIN = false;
    const bf16_t* G0; bf16_t* MG;
    DI void operator()(const f32x4 (&acc)[2][2][4][2], const Unit& u, int wr, int wc, int fr, int fq) const {
        const int br = u.pm >> 6, row0 = (u.pm & 63) * 256 + wr * 64 + fr, col0 = (u.pn & 3) * 256 + wc * 32 + 8 * fq;
        const bf16_t* G = G0 + (size_t)br * (16u << 20);
#pragma unroll
        for (int ai = 0; ai < 2; ++ai)
#pragma unroll
            for (int m = 0; m < 4; ++m)
#pragma unroll
                for (int bj = 0; bj < 2; ++bj) {
                    const size_t off = (size_t)(row0 + ai * 128 + m * 16) * DM + col0 + bj * 128;
                    const u32x4 g = *(const u32x4*)(G + off); const f32x4 a = acc[ai][bj][m][0], b = acc[ai][bj][m][1];
                    float o[8] = {bflo(g.x) * a[0], bfhi(g.x) * a[1], bflo(g.y) * a[2], bfhi(g.y) * a[3], bflo(g.z) * b[0], bfhi(g.z) * b[1], bflo(g.w) * b[2], bfhi(g.w) * b[3]};
                    if (br > 0) { const u32x4 p = *(const u32x4*)(MG + off); o[0] += bflo(p.x); o[1] += bfhi(p.x); o[2] += bflo(p.y); o[3] += bfhi(p.y); o[4] += bflo(p.z); o[5] += bfhi(p.z); o[6] += bflo(p.w); o[7] += bfhi(p.w); }
                    u32x4 w; w.x = pk2(o[0], o[1]); w.y = pk2(o[2], o[3]); w.z = pk2(o[4], o[5]); w.w = pk2(o[6], o[7]); *(u32x4*)(MG + off) = w;
                }
    }
};

__constant__ float ROPE_INV[16] = {1.0f, 0.5623413324356079f, 0.3162277638912201f, 0.17782793939113617f, 0.10000000149011612f, 0.05623413249850273f, 0.03162277489900589f, 0.017782794311642647f,
                                   0.009999999776482582f, 0.005623413249850273f, 0.003162277629598975f, 0.0017782794311642647f, 0.0010000000474974513f, 0.000562341301701963f, 0.0003162277571391314f, 0.00017782794020604342f};
#define MFMA32(a, b, c) __builtin_amdgcn_mfma_f32_32x32x16_bf16((a), (b), (c), 0, 0, 0)
DI float xhalf_max(float m) { auto rr = __builtin_amdgcn_permlane32_swap(__float_as_uint(m), __float_as_uint(m), false, false); return __builtin_fmaxf(__uint_as_float(rr[0]), __uint_as_float(rr[1])); }
DI float xhalf_sum(float m) { auto rr = __builtin_amdgcn_permlane32_swap(__float_as_uint(m), __float_as_uint(m), false, false); return __uint_as_float(rr[0]) + __uint_as_float(rr[1]); }
template <int DQK, int DV, bool CAUSAL, int KT, bool PRIO>
DI void attn_unit(const bf16_t* Qb, int qpitch, const bf16_t* Kb, int kpitch, const bf16_t* Vtb, int vpitch, bf16_t* Ob, int opitch, int q0, int nt, LAS unsigned char* lds, float kbound, const float* qgain, const int* qpos, float qscale) {
    constexpr int KS = DQK * 2 + 16, VS = KT * 2 + 8, KBUF = KT * KS, VBUF = DV * VS, VOFF = 2 * KBUF;
    constexpr int KCH = DQK / 8, NKC = KT * KCH, NKR = (NKC + 511) / 512, VCH = KT / 8, NVC = DV * VCH, NVR = NVC / 512;
    constexpr float THR = 8.0f;
    static_assert(NVC % 512 == 0 && VOFF + 2 * VBUF <= 131072, "attention staging geometry");
    int tid_ = threadIdx.x; asm volatile("" : "+v"(tid_));
    const int tid = tid_, lane = tid & 63, r = lane & 31, h = lane >> 5, w = __builtin_amdgcn_readfirstlane(tid >> 6);
    u32x4 kreg[NKR], vreg[NVR];
    auto gload = [&](int kt) {
#pragma unroll
        for (int i = 0; i < NKR; ++i) { const int c = tid + i * 512; if (NKC % 512 == 0 || c < NKC) kreg[i] = *(const u32x4*)(Kb + (size_t)(kt * KT + c / KCH) * kpitch + (c % KCH) * 8); }
#pragma unroll
        for (int i = 0; i < NVR; ++i) { const int c = tid + i * 512; vreg[i] = *(const u32x4*)(Vtb + (size_t)(c / VCH) * vpitch + kt * KT + (c % VCH) * 8); }
    };
    auto lstore = [&](int buf) {
#pragma unroll
        for (int i = 0; i < NKR; ++i) { const int c = tid + i * 512; if (NKC % 512 == 0 || c < NKC) *(LAS u32x4*)(lds + buf * KBUF + (c / KCH) * KS + (c % KCH) * 16) = kreg[i]; }
#pragma unroll
        for (int i = 0; i < NVR; ++i) { const int c = tid + i * 512; LAS unsigned char* p = lds + VOFF + buf * VBUF + (c / VCH) * VS + (c % VCH) * 16;
            *(LAS u32x2*)p = (u32x2){vreg[i].x, vreg[i].y}; *(LAS u32x2*)(p + 8) = (u32x2){vreg[i].z, vreg[i].w}; }
    };
    gload(0);
    bf16x8 qf[DQK / 16];
#pragma unroll
    for (int ks = 0; ks < DQK / 16; ++ks) qf[ks] = *(const bf16x8*)(Qb + (size_t)(32 * w + r) * qpitch + 16 * ks + 8 * h);
    if (qgain) {
        float v[DQK / 16][8]; float q2 = 0.f;
#pragma unroll
        for (int ks = 0; ks < DQK / 16; ++ks)
#pragma unroll
            for (int e = 0; e < 8; ++e) { v[ks][e] = __uint_as_float(((unsigned)(unsigned short)qf[ks][e]) << 16); q2 += v[ks][e] * v[ks][e]; }
        q2 = xhalf_sum(q2);
        const float rq = __builtin_amdgcn_rsqf(q2 * (1.0f / (float)DQK) + EPS) * qscale;
#pragma unroll
        for (int ks = 0; ks < DQK / 16; ++ks) { const f32x4 g0 = *(const f32x4*)(qgain + 16 * ks + 8 * h), g1 = *(const f32x4*)(qgain + 16 * ks + 8 * h + 4);
#pragma unroll
            for (int e = 0; e < 4; ++e) { v[ks][e] *= rq * g0[e]; v[ks][4 + e] *= rq * g1[e]; } }
        if (DQK == 96 && qpos) {
        const float pos = (float)qpos[32 * w + r];
#pragma unroll
        for (int e = 0; e < 8; ++e) {
            const float ang = pos * ROPE_INV[8 * h + e]; const double rev = (double)ang * 0.15915494309189535; const float f = (float)(rev - floor(rev));
            const float c = __builtin_amdgcn_cosf(f), sn_ = __builtin_amdgcn_sinf(f), x1 = v[4][e], x2 = v[5][e];
            v[4][e] = x1 * c - x2 * sn_; v[5][e] = x2 * c + x1 * sn_; }
        }
#pragma unroll
        for (int ks = 0; ks < DQK / 16; ++ks) { u32x4 pw; pw.x = pk2(v[ks][0], v[ks][1]); pw.y = pk2(v[ks][2], v[ks][3]); pw.z = pk2(v[ks][4], v[ks][5]); pw.w = pk2(v[ks][6], v[ks][7]); qf[ks] = __builtin_bit_cast(bf16x8, pw); }
    }
    f32x16 o[DV / 32], negm;
#pragma unroll
    for (int i = 0; i < 16; ++i) negm[i] = 0.f;
#pragma unroll
    for (int d = 0; d < DV / 32; ++d)
#pragma unroll
        for (int i = 0; i < 16; ++i) o[d][i] = 0.f;
    float mrun = 0.f, lrun = 0.f; bool first = true;
    bool nomax = false;
    if (PRIO) {
        float q2 = 0.f;
#pragma unroll
        for (int ks = 0; ks < DQK / 16; ++ks)
#pragma unroll
            for (int e = 0; e < 8; ++e) { const float v = __uint_as_float(((unsigned)(unsigned short)qf[ks][e]) << 16); q2 += v * v; }
        q2 = xhalf_sum(q2);
        nomax = __all(sqrtf(q2) * kbound <= 100.0f) != 0;
    }
    lstore(0);
    __syncthreads();
    const int qabs = q0 + 32 * w + r, qlo = q0 + 32 * w;
    for (int kt = 0; kt < nt; ++kt) {
        const int buf = kt & 1;
        if (kt + 1 < nt) gload(kt + 1);
#pragma unroll
        for (int hf = 0; hf < KT / 64; ++hf) {
            const int key0 = kt * KT + 64 * hf;
            if (!CAUSAL || key0 <= qlo + 31) {
                if (PRIO) {
                    constexpr int KSN = DQK / 16, NDB = DV / 32;
                    f32x16 s0 = negm, s1 = negm;
                    const LAS unsigned char* kb = lds + buf * KBUF + (64 * hf + r) * KS + h * 16;
                    const LAS unsigned char* vb = lds + VOFF + buf * VBUF + r * VS + h * 8 + 128 * hf;
                    bf16x8 kf0[KSN], kf1[KSN], vf[4][NDB];
#pragma unroll
                    for (int ks = 0; ks < KSN; ++ks) { kf0[ks] = *(const LAS bf16x8*)(kb + ks * 32); kf1[ks] = *(const LAS bf16x8*)(kb + 32 * KS + ks * 32); }
                    __builtin_amdgcn_sched_barrier(0); __builtin_amdgcn_s_setprio(1); __builtin_amdgcn_sched_barrier(0);
#pragma unroll
                    for (int ks = 0; ks < KSN; ++ks) { s0 = MFMA32(kf0[ks], qf[ks], s0); s1 = MFMA32(kf1[ks], qf[ks], s1); }
                    __builtin_amdgcn_sched_barrier(0); __builtin_amdgcn_s_setprio(0); __builtin_amdgcn_sched_barrier(0);
#pragma unroll
                    for (int q4 = 0; q4 < 4; ++q4)
#pragma unroll
                        for (int d = 0; d < NDB; ++d) { const LAS unsigned char* vp = vb + d * 32 * VS + q4 * 32;
                            const s16x4 lo = *(const LAS s16x4*)vp, hi = *(const LAS s16x4*)(vp + 16); vf[q4][d] = (bf16x8){lo[0], lo[1], lo[2], lo[3], hi[0], hi[1], hi[2], hi[3]}; }
                    if (CAUSAL && key0 + 63 > qlo) {
#pragma unroll
                        for (int i = 0; i < 16; ++i) { const int key = key0 + (i & 3) + 8 * (i >> 2) + 4 * h; if (key > qabs) s0[i] = -1e30f; if (key + 32 > qabs) s1[i] = -1e30f; }
                    }
                    if (!nomax) {
                    float ra = __builtin_fmaxf(__builtin_fmaxf(s0[0], s0[1]), s1[0]), rb = __builtin_fmaxf(__builtin_fmaxf(s0[2], s0[3]), s1[1]);
                    ra = __builtin_fmaxf(__builtin_fmaxf(ra, s1[2]), s1[3]);
#pragma unroll
                    for (int i = 4; i < 16; i += 4) { ra = __builtin_fmaxf(__builtin_fmaxf(ra, s0[i]), s0[i + 1]); rb = __builtin_fmaxf(__builtin_fmaxf(rb, s0[i + 2]), s0[i + 3]);
                        ra = __builtin_fmaxf(__builtin_fmaxf(ra, s1[i]), s1[i + 1]); rb = __builtin_fmaxf(__builtin_fmaxf(rb, s1[i + 2]), s1[i + 3]); }
                    float rm = __builtin_fmaxf(ra, rb);
                    rm = xhalf_max(rm);
                    if (first || __any(rm > THR)) {
                        const float dl = first ? rm : fmaxf(rm, 0.f), f = __builtin_amdgcn_exp2f(-dl);
                        mrun += dl; lrun *= f; first = false;
#pragma unroll
                        for (int i = 0; i < 16; ++i) { s0[i] -= dl; s1[i] -= dl; negm[i] = -mrun; }
#pragma unroll
                        for (int d = 0; d < NDB; ++d)
#pragma unroll
                            for (int i = 0; i < 16; ++i) o[d][i] *= f;
                    }
                    }
                    float ps = 0.f;
#pragma unroll
                    for (int i = 0; i < 16; ++i) { s0[i] = __builtin_amdgcn_exp2f(s0[i]); ps += s0[i]; asm volatile("" : "+v"(ps)); }
#pragma unroll
                    for (int i = 0; i < 16; ++i) { s1[i] = __builtin_amdgcn_exp2f(s1[i]); ps += s1[i]; asm volatile("" : "+v"(ps)); }
                    lrun += ps;
                    bf16x8 pf[4];
#pragma unroll
                    for (int sf = 0; sf < 2; ++sf) {
                        u32x4 pw; pw.x = pk2(s0[8 * sf], s0[8 * sf + 1]); pw.y = pk2(s0[8 * sf + 2], s0[8 * sf + 3]); pw.z = pk2(s0[8 * sf + 4], s0[8 * sf + 5]); pw.w = pk2(s0[8 * sf + 6], s0[8 * sf + 7]); pf[sf] = __builtin_bit_cast(bf16x8, pw);
                        u32x4 pv; pv.x = pk2(s1[8 * sf], s1[8 * sf + 1]); pv.y = pk2(s1[8 * sf + 2], s1[8 * sf + 3]); pv.z = pk2(s1[8 * sf + 4], s1[8 * sf + 5]); pv.w = pk2(s1[8 * sf + 6], s1[8 * sf + 7]); pf[2 + sf] = __builtin_bit_cast(bf16x8, pv);
                    }
                    __builtin_amdgcn_sched_barrier(0); __builtin_amdgcn_s_setprio(1); __builtin_amdgcn_sched_barrier(0);
#pragma unroll
                    for (int q4 = 0; q4 < 4; ++q4)
#pragma unroll
                        for (int d = 0; d < NDB; ++d) o[d] = MFMA32(vf[q4][d], pf[q4], o[d]);
                    __builtin_amdgcn_sched_barrier(0); __builtin_amdgcn_s_setprio(0); __builtin_amdgcn_sched_barrier(0);
                } else {
                    f32x16 s0, s1;
                    if (PRIO) { s0 = negm; s1 = negm; } else {
#pragma unroll
                        for (int i = 0; i < 16; ++i) { s0[i] = 0.f; s1[i] = 0.f; } }
                    const LAS unsigned char* kb = lds + buf * KBUF + (64 * hf + r) * KS + h * 16;
                    if (PRIO) __builtin_amdgcn_s_setprio(1);
#pragma unroll
                    for (int ks = 0; ks < DQK / 16; ++ks) {
                        const bf16x8 a0 = *(const LAS bf16x8*)(kb + ks * 32), a1 = *(const LAS bf16x8*)(kb + 32 * KS + ks * 32);
                        s0 = MFMA32(a0, qf[ks], s0); s1 = MFMA32(a1, qf[ks], s1);
                    }
                    if (PRIO) __builtin_amdgcn_s_setprio(0);
                    if (CAUSAL && key0 + 63 > qlo) {
#pragma unroll
                        for (int i = 0; i < 16; ++i) { const int key = key0 + (i & 3) + 8 * (i >> 2) + 4 * h; if (key > qabs) s0[i] = -1e30f; if (key + 32 > qabs) s1[i] = -1e30f; }
                    }
                    if (!PRIO) {
#pragma unroll
                        for (int i = 0; i < 16; ++i) { s0[i] -= mrun; s1[i] -= mrun; } }
                    float rm = fmaxf(s0[0], s1[0]);
#pragma unroll
                    for (int i = 1; i < 16; ++i) rm = fmaxf(rm, fmaxf(s0[i], s1[i]));
                    rm = xhalf_max(rm);
                    if (first || __any(rm > THR)) {
                        const float dl = first ? rm : fmaxf(rm, 0.f), f = __builtin_amdgcn_exp2f(-dl);
                        mrun += dl; lrun *= f; first = false;
#pragma unroll
                        for (int i = 0; i < 16; ++i) { s0[i] -= dl; s1[i] -= dl; if (PRIO) negm[i] = -mrun; }
#pragma unroll
                        for (int d = 0; d < DV / 32; ++d)
#pragma unroll
                            for (int i = 0; i < 16; ++i) o[d][i] *= f;
                    }
                    const LAS unsigned char* vb = lds + VOFF + buf * VBUF + r * VS + h * 8 + 128 * hf;
                    float ps = 0.f;
#pragma unroll
                    for (int kb2 = 0; kb2 < 2; ++kb2) {
                        f32x16& sx = kb2 == 0 ? s0 : s1;
#pragma unroll
                        for (int i = 0; i < 16; ++i) { sx[i] = __builtin_amdgcn_exp2f(sx[i]); ps += sx[i]; }
                        if (PRIO) __builtin_amdgcn_s_setprio(1);
#pragma unroll
                        for (int sf = 0; sf < 2; ++sf) {
                            u32x4 pw; pw.x = pk2(sx[8 * sf], sx[8 * sf + 1]); pw.y = pk2(sx[8 * sf + 2], sx[8 * sf + 3]); pw.z = pk2(sx[8 * sf + 4], sx[8 * sf + 5]); pw.w = pk2(sx[8 * sf + 6], sx[8 * sf + 7]);
                            const bf16x8 pf = __builtin_bit_cast(bf16x8, pw);
#pragma unroll
                            for (int d = 0; d < DV / 32; ++d) {
                                const LAS unsigned char* vp = vb + d * 32 * VS + (32 * kb2 + 16 * sf) * 2;
                                const s16x4 lo = *(const LAS s16x4*)vp, hi = *(const LAS s16x4*)(vp + 16);
                                const bf16x8 a = (bf16x8){lo[0], lo[1], lo[2], lo[3], hi[0], hi[1], hi[2], hi[3]};
                                o[d] = MFMA32(a, pf, o[d]);
                                if (!PRIO) asm volatile("" ::: "memory");
                            }
                        }
                        if (PRIO) __builtin_amdgcn_s_setprio(0);
                    }
                    lrun += ps;
                }
            }
        }
        if (kt + 1 < nt) lstore(buf ^ 1);
        __syncthreads();
    }
    lrun = xhalf_sum(lrun);
    const float inv = 1.0f / lrun;
    bf16_t* orow = Ob + (size_t)(32 * w + r) * opitch;
#pragma unroll
    for (int d = 0; d < DV / 32; ++d)
#pragma unroll
        for (int g = 0; g < 4; ++g) { u32x2 wv; wv.x = pk2(o[d][4 * g] * inv, o[d][4 * g + 1] * inv); wv.y = pk2(o[d][4 * g + 2] * inv, o[d][4 * g + 3] * inv);
            *(u32x2*)(orow + 32 * d + 8 * g + 4 * h) = wv; }
}

#define MFMA16(a, b, c) __builtin_amdgcn_mfma_f32_16x16x32_bf16((a), (b), (c), 0, 0, 0)
DI void sgu_item(int g, int bc, int par, const bf16_t* SGW, const bf16_t* Vg, const float* VST, const float* lng, const float* lnb, const float* sgb, bf16_t* U, LAS unsigned char* lds) {
    constexpr int RS = 272;
    const int tid = threadIdx.x, lane = tid & 63, w = __builtin_amdgcn_readfirstlane(tid >> 6), row0 = bc * 128;
    LAS unsigned char* Wl = lds + par * (192 * RS); LAS unsigned char* Vl = Wl + 128 * RS;
    const int j = lane & 15, q = lane >> 4, t0 = 16 * w, nks = (t0 + 15) / 32 + 1, t = t0 + j;
    u32x4 wreg[4];
#pragma unroll
    for (int i = 0; i < 4; ++i) { const int c = tid + i * 512, rr = c >> 4, cc = c & 15; wreg[i] = *(const u32x4*)(SGW + (size_t)g * 16384 + rr * 128 + cc * 8); }
    const int s = tid & 127, dg = tid >> 7, row = row0 + s;
    f32x4 pst[8];
#pragma unroll
    for (int i = 0; i < 8; ++i) pst[i] = *(const f32x4*)(VST + (size_t)row * 32 + 4 * i);
    const u32x4 a = *(const u32x4*)(Vg + (size_t)row * 512 + g * 64 + dg * 16), b = *(const u32x4*)(Vg + (size_t)row * 512 + g * 64 + dg * 16 + 8);
    bf16_t* up = U + (size_t)(row0 + t) * 512 + g * 64 + 4 * q;
    u32x2 uu[4];
#pragma unroll
    for (int db = 0; db < 4; ++db) uu[db] = *(const u32x2*)(up + 16 * db);
    const float bias = sgb[g * 128 + t];
#pragma unroll
    for (int i = 0; i < 4; ++i) { const int c = tid + i * 512, rr = c >> 4, cc = c & 15; *(LAS u32x4*)(Wl + rr * RS + cc * 16) = wreg[i]; }
    {
        float s1 = 0.f, s2 = 0.f;
#pragma unroll
        for (int i = 0; i < 8; ++i) { s1 += pst[i][0] + pst[i][2]; s2 += pst[i][1] + pst[i][3]; }
        const float mu = s1 * (1.0f / 512.0f), var = s2 * (1.0f / 512.0f) - mu * mu, rstd = __builtin_amdgcn_rsqf(fmaxf(var, 0.f) + EPS);
        const unsigned wd[8] = {a.x, a.y, a.z, a.w, b.x, b.y, b.z, b.w};
#pragma unroll
        for (int i = 0; i < 8; ++i) {
            const int d = dg * 16 + 2 * i, c = g * 64 + d;
            const float v0 = (bflo(wd[i]) - mu) * rstd * lng[c] + lnb[c], v1 = (bfhi(wd[i]) - mu) * rstd * lng[c + 1] + lnb[c + 1];
            *(LAS bf16_t*)(Vl + d * RS + s * 2) = (bf16_t)f2bf(v0); *(LAS bf16_t*)(Vl + (d + 1) * RS + s * 2) = (bf16_t)f2bf(v1);
        }
    }
    __syncthreads();
    f32x4 acc[4];
#pragma unroll
    for (int db = 0; db < 4; ++db) acc[db] = (f32x4){0.f, 0.f, 0.f, 0.f};
    for (int ks = 0; ks < nks; ++ks) {
        const bf16x8 bw = *(const LAS bf16x8*)(Wl + (t0 + j) * RS + (32 * ks + 8 * q) * 2);
#pragma unroll
        for (int db = 0; db < 4; ++db) { const bf16x8 av = *(const LAS bf16x8*)(Vl + (16 * db + j) * RS + (32 * ks + 8 * q) * 2); acc[db] = MFMA16(av, bw, acc[db]); }
    }
#pragma unroll
    for (int db = 0; db < 4; ++db) {
        u32x2 wv; wv.x = pk2(bflo(uu[db].x) * (acc[db][0] + bias), bfhi(uu[db].x) * (acc[db][1] + bias)); wv.y = pk2(bflo(uu[db].y) * (acc[db][2] + bias), bfhi(uu[db].y) * (acc[db][3] + bias));
        *(u32x2*)(up + 16 * db) = wv;
    }
}

DI float wave_sum(float v) {
#pragma unroll
    for (int o = 1; o < 64; o <<= 1) v += __shfl_xor(v, o);
    return v;
}
DI bf16_t* dest_rows(int mode, int n0, int K, bf16_t* d0, bf16_t* d1) {
    if (mode == 1) { const int isu = n0 >= FF ? 1 : 0, c = n0 - isu * FF; return d0 + (size_t)((c >> 7) * 256 + isu * 128 + (c & 127)) * K; }
    if (mode == 2) {
        if (n0 < 1664) return d0 + (size_t)n0 * K;
        if (n0 < 1696) return d0 + (size_t)(2176 + n0 - 1664) * K;
        if (n0 < 2208) return d0 + (size_t)(1664 + n0 - 1696) * K;
        return d1 + (size_t)(n0 - 2208) * K;
    }
    return d0 + (size_t)n0 * K;
}
DI void transpose_mat(const float* W, int K, int N, const float* gk, int mode, bf16_t* d0, bf16_t* d1, LAS float* scr, int gw, int ngw, int lane, int nb0 = 0, int nb1 = -1) {
    if (nb1 < 0) nb1 = N / 32;
    const int nblk = nb1 - nb0, nitems = (K / 64) * nblk;
    for (int item = gw; item < nitems; item += ngw) {
        const int kb = item / nblk, nb = nb0 + item % nblk, k0 = 64 * kb, n0 = 32 * nb;
        float tv[32];
#pragma unroll
        for (int i = 0; i < 32; ++i) { const int kk = 2 * i + (lane >> 5); tv[i] = W[(size_t)(k0 + kk) * N + n0 + (lane & 31)]; }
#pragma unroll
        for (int i = 0; i < 32; ++i) { const int kk = 2 * i + (lane >> 5); float v = tv[i]; if (gk) v *= gk[k0 + kk]; scr[kk * 33 + (lane & 31)] = v; }
        asm volatile("s_waitcnt lgkmcnt(0)" ::: "memory");
        bf16_t* dst = dest_rows(mode, n0, K, d0, d1);
        const int c = lane & 7;
#pragma unroll
        for (int jj = 0; jj < 4; ++jj) { const int n = (lane >> 3) + 8 * jj; const LAS float* s = scr + (8 * c) * 33 + n;
            u32x4 o; o.x = pk2(s[0 * 33], s[1 * 33]); o.y = pk2(s[2 * 33], s[3 * 33]); o.z = pk2(s[4 * 33], s[5 * 33]); o.w = pk2(s[6 * 33], s[7 * 33]);
            *(u32x4*)(dst + (size_t)n * K + k0 + 8 * c) = o; }
        asm volatile("s_waitcnt lgkmcnt(0)" ::: "memory");
    }
}
DI void rms_row_to_bf16(const float* xrow, const float* gain, bf16_t* orow, int lane) {
    const f32x4* xr = (const f32x4*)xrow + lane;
    f32x4 v[4]; float s = 0.f;
#pragma unroll
    for (int jj = 0; jj < 4; ++jj) { v[jj] = xr[64 * jj]; s += (v[jj][0] * v[jj][0] + v[jj][1] * v[jj][1]) + (v[jj][2] * v[jj][2] + v[jj][3] * v[jj][3]); }
    const float rstd = 1.0f / sqrtf(wave_sum(s) * (1.0f / 1024.0f) + EPS);
    u32x2* o8 = (u32x2*)orow + lane;
#pragma unroll
    for (int jj = 0; jj < 4; ++jj) {
        f32x4 gg = (f32x4){1.f, 1.f, 1.f, 1.f}; if (gain) gg = ((const f32x4*)gain)[lane + 64 * jj];
        u32x2 wv; wv.x = pk2(v[jj][0] * rstd * gg[0], v[jj][1] * rstd * gg[1]); wv.y = pk2(v[jj][2] * rstd * gg[2], v[jj][3] * rstd * gg[3]); o8[64 * jj] = wv;
    }
}

#define RLX_AGENT __ATOMIC_RELAXED, __HIP_MEMORY_SCOPE_AGENT
#define XB_TMO      128
#define XB_XCNT(j)  (256  + 64 * (j))
#define XB_XSUB(j)  (1280 + 64 * (j))
#define XB_XGEN(j)  (2304 + 64 * (j))
#define XB_TOP      3328
#define XB_TOPGEN   3392
#define XCD_BAR_WORDS 3456
#define XB_SPIN_CAP (1u << 18)

__device__ __forceinline__ unsigned xb_ld(unsigned* p)              { return __hip_atomic_load(p, __ATOMIC_RELAXED, __HIP_MEMORY_SCOPE_AGENT); }
__device__ __forceinline__ unsigned xb_add(unsigned* p, unsigned v) { return __hip_atomic_fetch_add(p, v, __ATOMIC_RELAXED, __HIP_MEMORY_SCOPE_AGENT); }
__device__ __forceinline__ unsigned xb_xcc_id() { return (unsigned)__builtin_amdgcn_s_getreg((3 << 11) | 20) & 0xFu; }
#define XB_SPIN(cond, bar) do { unsigned _sp = 0; while (cond) { __builtin_amdgcn_s_sleep(1); \
    if ((++_sp & 255u) == 0u) { if (xb_ld(&(bar)[XB_TMO])) break; if (_sp > XB_SPIN_CAP) { atomicAdd(&(bar)[XB_TMO], 1u); break; } } } } while (0)

struct XcdBarrier {
    unsigned* bar; unsigned x;
    volatile LAS unsigned* st;
};

__device__ __forceinline__ XcdBarrier xcd_barrier_post(unsigned* bar, volatile LAS unsigned* st) {
    XcdBarrier b; b.bar = bar; b.x = xb_xcc_id(); b.st = st;
    if (threadIdx.x == 0) (void)xb_add(&bar[XB_XCNT(b.x)], 1u);
    return b;
}
__device__ __forceinline__ void xcd_barrier_complete(unsigned* bar, unsigned x, unsigned& nloc, unsigned& nx) {
    const unsigned G = gridDim.x * gridDim.y * gridDim.z;
    unsigned sum, cnt, mine, sp = 0u;
    for (;;) {
        sum = 0u; cnt = 0u; mine = 0u;
#pragma unroll
        for (unsigned j = 0; j < 16; ++j) { const unsigned c = xb_ld(&bar[XB_XCNT(j)]); sum += c; cnt += (c > 0u) ? 1u : 0u; mine = (j == x) ? c : mine; }
        if (sum == G) break;
        __builtin_amdgcn_s_sleep(1);
        if ((++sp & 255u) == 0u) { if (xb_ld(&bar[XB_TMO])) break; if (sp > XB_SPIN_CAP) { atomicAdd(&bar[XB_TMO], 1u); break; } }
    }
    nloc = mine > 0u ? mine : 1u; nx = cnt > 0u ? cnt : 1u;
}

__device__ __forceinline__ void xcd_barrier(const XcdBarrier& b) {
    asm volatile("s_waitcnt vmcnt(0)" ::: "memory");
    __syncthreads();
    if (threadIdx.x == 0) {
        unsigned* bar = b.bar;
        __builtin_amdgcn_s_waitcnt(0);
        unsigned nloc = b.st[0], nx = b.st[1];
        if (nloc == 0u) { xcd_barrier_complete(bar, b.x, nloc, nx); b.st[0] = nloc; b.st[1] = nx; }
        const unsigned old = xb_add(&bar[XB_XSUB(b.x)], 1u);
        const unsigned gen = old / nloc;
        if (old + 1u == (gen + 1u) * nloc) {
            __builtin_amdgcn_fence(__ATOMIC_RELEASE, "agent");
            asm volatile("s_waitcnt vmcnt(0)" ::: "memory");
            const unsigned og = xb_add(&bar[XB_TOP], 1u);
            const unsigned tg = og / nx;
            if (og + 1u == (tg + 1u) * nx) xb_add(&bar[XB_TOPGEN], 1u);
            else XB_SPIN(xb_ld(&bar[XB_TOPGEN]) == tg, bar);
            __builtin_amdgcn_fence(__ATOMIC_ACQUIRE, "agent");
            xb_add(&bar[XB_XGEN(b.x)], 1u);
            asm volatile("s_waitcnt vmcnt(0)" ::: "memory");
        } else {
            XB_SPIN(xb_ld(&bar[XB_XGEN(b.x)]) == gen, bar);
            __builtin_amdgcn_fence(__ATOMIC_ACQUIRE, "agent");
            asm volatile("s_waitcnt vmcnt(0)" ::: "memory");
        }
    }
    __syncthreads();
}

struct Args { const float* in[30]; float* out; unsigned char* ws; int ph_lo, ph_hi; };
constexpr int LDS_BYTES = 135168;
constexpr int NPH = 12;


#define wGU1 ((bf16_t*)(ws + W_GU1))
#define wDN1 ((bf16_t*)(ws + W_DN1))
#define wIN ((bf16_t*)(ws + W_IN))
#define wGT ((bf16_t*)(ws + W_GT))
#define wUQ ((bf16_t*)(ws + W_UQ))
#define wUKV ((bf16_t*)(ws + W_UKV))
#define wMKV ((bf16_t*)(ws + W_MKV))
#define wBA ((bf16_t*)(ws + W_BA))
#define wBB ((bf16_t*)(ws + W_BB))
#define wBC ((bf16_t*)(ws + W_BC))
#define wOUT ((bf16_t*)(ws + W_OUT))
#define wGU2 ((bf16_t*)(ws + W_GU2))
#define wDN2 ((bf16_t*)(ws + W_DN2))
#define wSG ((bf16_t*)(ws + W_SG))
#define SS1 ((float*)(ws + S_SS1))
#define SS2 ((float*)(ws + S_SS2))
#define VST ((float*)(ws + S_VST))
#define CQP ((float*)(ws + S_CQP))
#define CKVP ((float*)(ws + S_CKVP))
#define QMP ((float*)(ws + S_QMP))
#define KR ((float*)(ws + S_KR))
#define MEMN ((bf16_t*)(ws + S_MEMN))
#define MKV ((float*)(ws + S_MKV))
#define KM ((bf16_t*)(ws + S_KM))
#define VMT ((bf16_t*)(ws + S_VMT))
#define X1B ((bf16_t*)(ws + B_X1B))
#define MG ((bf16_t*)(ws + B_MG))
#define U ((bf16_t*)(ws + B_U))
#define QM ((bf16_t*)(ws + B_QM))
#define VG ((bf16_t*)(ws + B_VG))
#define KF ((bf16_t*)(ws + B_K))
#define CQ ((bf16_t*)(ws + B_CQ))
#define CKV ((bf16_t*)(ws + B_CKV))
#define QRAW ((bf16_t*)(ws + B_QRAW))
#define KN ((bf16_t*)(ws + B_KN))
#define VT ((bf16_t*)(ws + B_VT))
#define YB ((bf16_t*)(ws + B_YB))
#define YC ((bf16_t*)(ws + B_YC))
#define G0 ((bf16_t*)(ws + B_G0))
#define G1 ((bf16_t*)(ws + B_G1))
#define G2 ((bf16_t*)(ws + B_G2))
#define ACT ((bf16_t*)(ws + B_ACT))
#define XB ((bf16_t*)(ws + B_XB))
#define X2B ((bf16_t*)(ws + B_X2B))
#define MGO ((bf16_t*)out)
DI unsigned char* opaque_ptr(unsigned char* p) { asm volatile("" : "+s"(p)); return p; }
__global__ void __launch_bounds__(512, 2) fwd_mega(Args args) {
    extern __shared__ __attribute__((aligned(16))) unsigned char lds_raw[];
    LAS unsigned char* lds = (LAS unsigned char*)lds_raw;
    cg::grid_group grid = cg::this_grid();
    const int tid = threadIdx.x, lane = tid & 63, wave = __builtin_amdgcn_readfirstlane(tid >> 6);
    const int G = gridDim.x, bx = blockIdx.x;
    const float* x = args.in[0]; const float* mem = args.in[1]; const int* positions = (const int*)args.in[2];
    float* out = args.out;
    const int lo = args.ph_lo, hi = args.ph_hi;
#ifndef PH_MASK
#define PH_MASK 0xFFF
#endif
#define IN(k) (((PH_MASK >> (k)) & 1) && lo <= (k) && (k) < hi)
#ifndef DUP_MASK
#define DUP_MASK 0
#endif
#define DUP(k) for (int rep_ = 0; rep_ < 1 + ((DUP_MASK >> (k)) & 1); ++rep_)
#define SEAM(k) do { if (IN(k) && IN((k) + 1)) xcd_barrier(xbar); } while (0)
    if (args.ph_lo < 0) grid.sync();
    if (tid < 4) ((LAS unsigned*)(lds + 131072 + 1024))[tid] = 0u;
    __syncthreads();
    XcdBarrier xbar = xcd_barrier_post((unsigned*)(args.ws + S_BAR), (volatile LAS unsigned*)(lds + 131072 + 1024));
    const int gw = bx * 8 + wave, ngw = G * 8, gt = bx * 512 + tid, ngt = G * 512;

    if (IN(0)) DUP(0) { unsigned char* ws = opaque_ptr(args.ws);
        LAS float* scr = (LAS float*)(lds + wave * 16384);
        const bool defer = (G == 256);
        transpose_mat(args.in[4], 1024, 5632, args.in[3], 1, wGU1, nullptr, scr, gw, ngw, lane);
        transpose_mat(args.in[20], 1024, 1024, nullptr, 0, wMKV, nullptr, scr, gw, ngw, lane);
        if (!defer) {
            transpose_mat(args.in[5], 2816, 1024, nullptr, 0, wDN1, nullptr, scr, gw, ngw, lane);
            transpose_mat(args.in[7], 1024, 5280, args.in[6], 2, wIN, wGT, scr, gw, ngw, lane);
            transpose_mat(args.in[14], 384, 768, args.in[13], 0, wUQ, nullptr, scr, gw, ngw, lane);
            transpose_mat(args.in[16], 256, 1024, args.in[15], 0, wUKV, nullptr, scr, gw, ngw, lane);
            transpose_mat(args.in[23], 512, 1024, nullptr, 0, wBA, nullptr, scr, gw, ngw, lane);
            transpose_mat(args.in[24], 512, 1024, nullptr, 0, wBB, nullptr, scr, gw, ngw, lane);
            transpose_mat(args.in[25], 512, 1024, nullptr, 0, wBC, nullptr, scr, gw, ngw, lane);
            transpose_mat(args.in[26], 1024, 1024, nullptr, 0, wOUT, nullptr, scr, gw, ngw, lane);
            transpose_mat(args.in[28], 1024, 5632, args.in[27], 1, wGU2, nullptr, scr, gw, ngw, lane);
            transpose_mat(args.in[29], 2816, 1024, nullptr, 0, wDN2, nullptr, scr, gw, ngw, lane);
        }
        for (int i = gt; i < 96 * 1024 / 8; i += ngt) ((u32x4*)(wIN + (size_t)2208 * 1024))[i] = (u32x4){0u, 0u, 0u, 0u};
        for (int i = gt; i < T; i += ngt) { SS1[i] = 0.f; SS2[i] = 0.f; CQP[i] = 0.f; CKVP[i] = 0.f; }
        for (int m = 2 * gw; m < T; m += 2 * ngw) {
            const f32x4* x0 = (const f32x4*)(x + (size_t)m * DM) + lane; const f32x4* x1 = x0 + DM / 4;
            f32x4 v0[4], v1[4]; float s0 = 0.f, s1 = 0.f;
#pragma unroll
            for (int jj = 0; jj < 4; ++jj) { v0[jj] = x0[64 * jj]; v1[jj] = x1[64 * jj]; }
#pragma unroll
            for (int jj = 0; jj < 4; ++jj) { s0 += (v0[jj][0] * v0[jj][0] + v0[jj][1] * v0[jj][1]) + (v0[jj][2] * v0[jj][2] + v0[jj][3] * v0[jj][3]);
                                             s1 += (v1[jj][0] * v1[jj][0] + v1[jj][1] * v1[jj][1]) + (v1[jj][2] * v1[jj][2] + v1[jj][3] * v1[jj][3]); }
            const float q0_ = sqrtf(wave_sum(s0) * (1.0f / 1024.0f) + EPS), q1_ = sqrtf(wave_sum(s1) * (1.0f / 1024.0f) + EPS), r0 = 1.0f / q0_, r1 = 1.0f / q1_;
            if (lane == 0) { ((float*)(ws + S_R0))[m] = q0_; ((float*)(ws + S_R0))[m + 1] = q1_; }
            u32x2* o0 = (u32x2*)(XB + (size_t)m * DM) + lane; u32x2* o1 = o0 + DM / 4;
#pragma unroll
            for (int jj = 0; jj < 4; ++jj) { u32x2 w0, w1; w0.x = pk2(v0[jj][0] * r0, v0[jj][1] * r0); w0.y = pk2(v0[jj][2] * r0, v0[jj][3] * r0); w1.x = pk2(v1[jj][0] * r1, v1[jj][1] * r1); w1.y = pk2(v1[jj][2] * r1, v1[jj][3] * r1);
                o0[64 * jj] = w0; o1[64 * jj] = w1; }
        }
        for (int m = gw; m < 512; m += ngw) rms_row_to_bf16(mem + (size_t)m * DM, args.in[19], MEMN + (size_t)m * DM, lane);
        { const float* sgw = args.in[11];
          for (int i = gt; i < 8 * 128 * 128 / 2; i += ngt) { const int e = 2 * i, s = e & 127, t = (e >> 7) & 127; const float a = s <= t ? sgw[e] : 0.f, b = (s + 1) <= t ? sgw[e + 1] : 0.f; ((unsigned*)wSG)[i] = pk2(a, b); } }
    }
    SEAM(0);
#ifdef EXTRA_SYNCS
    for (int i_ = 0; i_ < EXTRA_SYNCS; ++i_) xcd_barrier(xbar);
#endif
    if (IN(1)) DUP(1) { unsigned char* ws = opaque_ptr(args.ws);
        { pg8::Gemm g{XB, wGU1, T, 5632, 1024}; pg8::StaticOrder S; S.init(T, 5632, G, bx); EpiSwiglu<0> E{ACT, nullptr};
          pg8::gemm_phase<EpiSwiglu<0>, pg8::StaticOrder, true, true>(lds, g, S, E); }
        { pg8::Gemm g{MEMN, wMKV, 512, 1024, 1024}; pg8::StaticOrder S; S.init(512, 1024, G, (bx + 128) % G); EpiF32 E{MKV, 1024};
          pg8::gemm_phase<EpiF32, pg8::StaticOrder, true, true>(lds, g, S, E); }
        if (G == 256 && bx >= 136) {
            LAS float* scr = (LAS float*)(lds + wave * 16384); const int gw2 = (bx - 136) * 8 + wave, ngw2 = 120 * 8;
            transpose_mat(args.in[5], 2816, 1024, nullptr, 0, wDN1, nullptr, scr, gw2, ngw2, lane);
            transpose_mat(args.in[7], 1024, 5280, args.in[6], 2, wIN, wGT, scr, gw2, ngw2, lane, 0, 69);
            transpose_mat(args.in[14], 384, 768, args.in[13], 0, wUQ, nullptr, scr, gw2, ngw2, lane);
            transpose_mat(args.in[16], 256, 1024, args.in[15], 0, wUKV, nullptr, scr, gw2, ngw2, lane);
        }
    }
    SEAM(1);
    if (IN(2)) DUP(2) { unsigned char* ws = opaque_ptr(args.ws); const bool dry = rep_ < ((DUP_MASK >> 2) & 1);
        pg8::Gemm g{ACT, wDN1, T, 1024, FF}; pg8::StaticOrder S; S.init(T, 1024, G, bx); EpiResid<true, true, false> E{(const float*)(ws + S_R0), XB, nullptr, X1B, dry ? (float*)(ws + S_DUMMY) : SS1, 0.5f};
        pg8::gemm_phase<EpiResid<true, true, false>, pg8::StaticOrder, true, true>(lds, g, S, E);
    }
    SEAM(2);
    if (IN(3)) DUP(3) { unsigned char* ws = opaque_ptr(args.ws); const bool dry = rep_ < ((DUP_MASK >> 3) & 1);
        pg8::Gemm g{X1B, wIN, T, NWIN, 1024}; pg8::StaticOrder S; S.init(T, NWIN, G, bx); EpiWin E{SS1, U, VG, CQ, CKV, QM, KR, VST, dry ? (float*)(ws + S_DUMMY) : CQP, dry ? (float*)(ws + S_DUMMY) : CKVP, QMP};
        pg8::gemm_phase<EpiWin, pg8::StaticOrder, true, true>(lds, g, S, E);
        if (G == 256 && bx >= 64) {
            LAS float* scr = (LAS float*)(lds + wave * 16384); const int gw2 = (bx - 64) * 8 + wave, ngw2 = 192 * 8;
            transpose_mat(args.in[7], 1024, 5280, args.in[6], 2, wIN, wGT, scr, gw2, ngw2, lane, 69, 165);
            transpose_mat(args.in[23], 512, 1024, nullptr, 0, wBA, nullptr, scr, gw2, ngw2, lane);
            transpose_mat(args.in[24], 512, 1024, nullptr, 0, wBB, nullptr, scr, gw2, ngw2, lane);
            transpose_mat(args.in[25], 512, 1024, nullptr, 0, wBC, nullptr, scr, gw2, ngw2, lane);
            transpose_mat(args.in[26], 1024, 1024, nullptr, 0, wOUT, nullptr, scr, gw2, ngw2, lane);
            transpose_mat(args.in[28], 1024, 5632, args.in[27], 1, wGU2, nullptr, scr, gw2, ngw2, lane);
            transpose_mat(args.in[29], 2816, 1024, nullptr, 0, wDN2, nullptr, scr, gw2, ngw2, lane);
                {
                const float* mkn = args.in[22];
                for (int idx = gw2; idx < 512 * 4; idx += ngw2) {
                    const int row = idx >> 2, hd = idx & 3;
                    const float a = MKV[(size_t)row * 1024 + hd * 128 + 2 * lane], b = MKV[(size_t)row * 1024 + hd * 128 + 2 * lane + 1];
                    const float rk = __builtin_amdgcn_rsqf(wave_sum(a * a + b * b) * (1.0f / 128.0f) + EPS);
                    ((unsigned*)(KM + (size_t)row * 512 + hd * 128))[lane] = pk2(a * rk * mkn[2 * lane], b * rk * mkn[2 * lane + 1]);
                }
                for (int i = (bx - 64) * 512 + tid; i < 2 * 4 * 128 * 256; i += 192 * 512) { const int m = i & 255, d = (i >> 8) & 127, hd = (i >> 15) & 3, b = i >> 17;
                    VMT[i] = (bf16_t)f2bf(MKV[(size_t)(b * 256 + m) * 1024 + 512 + hd * 128 + d]); }
            }
        }
    }
    SEAM(3);
    if (IN(4)) DUP(4) { unsigned char* ws = opaque_ptr(args.ws); const bool dry = rep_ < ((DUP_MASK >> 4) & 1);
#ifndef NO_UQ
        { int kk = 384; asm volatile("" : "+s"(kk)); pg8::Gemm g{CQ, wUQ, T, 768, kk}; pg8::StaticOrder S; S.init(T, 768, G, bx); EpiUq E{CQP, QRAW};
          pg8::gemm_phase<EpiUq, pg8::StaticOrder, true, true>(lds, g, S, E); }
#endif
#ifndef NO_UKV
        { int kk = 256; asm volatile("" : "+s"(kk)); pg8::Gemm g{CKV, wUKV, T, 1024, kk}; pg8::StaticOrder S; S.init(T, 1024, G, bx); EpiUkv E{CKVP, KN, VT};
          pg8::gemm_phase<EpiUkv, pg8::StaticOrder, true, true>(lds, g, S, E); }
#endif
        __syncthreads();
#ifndef NO_SGU
        if (!dry) { int par = 0; for (int it = bx; it < 1024; it += G, par ^= 1) sgu_item(it >> 7, it & 127, par, wSG, VG, VST, args.in[9], args.in[10], args.in[12], U, lds); __syncthreads(); }
#endif
    }
    SEAM(4);
    if (IN(5)) { unsigned char* ws = opaque_ptr(args.ws);
        {
            constexpr int NB = 4;
            const float* qn = args.in[17]; const float* kn = args.in[18];
            const int m = lane & 15, grp = lane >> 4; const bool act = m < 12, isrope = m >= 8 && m < 12, isx1 = m < 10; const int mm = act ? m : 0, i0 = 8 * (m & 1);
            float gq[8], gk[8], inv[8];
#pragma unroll
            for (int e = 0; e < 8; ++e) { gq[e] = qn[8 * mm + e] * QSCALE_MLA; gk[e] = kn[8 * mm + e]; inv[e] = ROPE_INV[i0 + e]; }
#pragma unroll 1
            for (int it0 = gw * NB; it0 < T * 2; it0 += ngw * NB) {
                u32x4 qa[NB], ka[NB]; f32x4 kb0[NB], kb1[NB]; float pos[NB];
#pragma unroll
                for (int u = 0; u < NB; ++u) {
                    const int task = (it0 + u) * 4 + grp, tok = task >> 3, hd = task & 7;
                    pos[u] = (float)positions[tok];
                    qa[u] = (u32x4){0u, 0u, 0u, 0u}; ka[u] = (u32x4){0u, 0u, 0u, 0u}; kb0[u] = (f32x4){0.f, 0.f, 0.f, 0.f}; kb1[u] = (f32x4){0.f, 0.f, 0.f, 0.f};
                    if (m < 8) ka[u] = *(const u32x4*)(KN + (size_t)tok * 512 + hd * 64 + 8 * m);
                    if (isrope) { kb0[u] = *(const f32x4*)(KR + (size_t)tok * 32 + 8 * (m - 8)); kb1[u] = *(const f32x4*)(KR + (size_t)tok * 32 + 8 * (m - 8) + 4); }
                }
#pragma unroll
                for (int u = 0; u < NB; ++u) {
                    const int task = (it0 + u) * 4 + grp, tok = task >> 3, hd = task & 7;
                    float cs[8], sn[8];
#pragma unroll
                    for (int e = 0; e < 8; ++e) { const float ang = pos[u] * inv[e]; const double rev = (double)ang * 0.15915494309189535; const float f = (float)(rev - floor(rev));
                        cs[e] = __builtin_amdgcn_cosf(f); sn[e] = __builtin_amdgcn_sinf(f); }
                    float v[8];
                    {
                        const u32x4 a = ka[u];
                        if (m < 8) { v[0] = bflo(a.x); v[1] = bfhi(a.x); v[2] = bflo(a.y); v[3] = bfhi(a.y); v[4] = bflo(a.z); v[5] = bfhi(a.z); v[6] = bflo(a.w); v[7] = bfhi(a.w); }
                        else { v[0] = kb0[u][0]; v[1] = kb0[u][1]; v[2] = kb0[u][2]; v[3] = kb0[u][3]; v[4] = kb1[u][0]; v[5] = kb1[u][1]; v[6] = kb1[u][2]; v[7] = kb1[u][3]; }
                        float ss = 0.f;
#pragma unroll
                        for (int e = 0; e < 8; ++e) ss += v[e] * v[e];
                        ss += __shfl_xor(ss, 1); ss += __shfl_xor(ss, 2); ss += __shfl_xor(ss, 4); ss += __shfl_xor(ss, 8);
                        const float rk = __builtin_amdgcn_rsqf(ss * (1.0f / 96.0f) + EPS);
#pragma unroll
                        for (int e = 0; e < 8; ++e) v[e] = v[e] * rk * gk[e];
#pragma unroll
                        for (int e = 0; e < 8; ++e) { const float o = __shfl_xor(v[e], 2); if (isrope) v[e] = isx1 ? v[e] * cs[e] - o * sn[e] : v[e] * cs[e] + o * sn[e]; }
                        if (act) { u32x4 w; w.x = pk2(v[0], v[1]); w.y = pk2(v[2], v[3]); w.z = pk2(v[4], v[5]); w.w = pk2(v[6], v[7]); *(u32x4*)(KF + (size_t)tok * 768 + hd * 96 + 8 * m) = w; }
                    }
                }
            }
        }
        if (G != 256) {
            const float* mkn = args.in[22];
            for (int idx = gw; idx < 512 * 4; idx += ngw) {
                const int row = idx >> 2, hd = idx & 3;
                const float a = MKV[(size_t)row * 1024 + hd * 128 + 2 * lane], b = MKV[(size_t)row * 1024 + hd * 128 + 2 * lane + 1];
                const float rk = __builtin_amdgcn_rsqf(wave_sum(a * a + b * b) * (1.0f / 128.0f) + EPS);
                ((unsigned*)(KM + (size_t)row * 512 + hd * 128))[lane] = pk2(a * rk * mkn[2 * lane], b * rk * mkn[2 * lane + 1]);
            }
            for (int i = gt; i < 2 * 4 * 128 * 256; i += ngt) { const int m = i & 255, d = (i >> 8) & 127, hd = (i >> 15) & 3, b = i >> 17;
                VMT[i] = (bf16_t)f2bf(MKV[(size_t)(b * 256 + m) * 1024 + 512 + hd * 128 + d]); }
        }
    }
    SEAM(5);
    if (IN(6)) DUP(6) { unsigned char* ws = opaque_ptr(args.ws);
        const int vcu = (G % 8 == 0) ? (bx % 8) * (G / 8) + bx / 8 : bx;
        float kbound;
        { const float* kng = args.in[18]; float gmx = fabsf(kng[lane]); if (lane < 32) gmx = fmaxf(gmx, fabsf(kng[64 + lane]));
#pragma unroll
          for (int o_ = 1; o_ < 64; o_ <<= 1) gmx = fmaxf(gmx, __shfl_xor(gmx, o_));
          kbound = gmx * 9.797958971f * 1.01f; }
#ifndef NO_MLA
        for (int p = vcu; p < 256; p += G) {
            const int bh = p >> 4, s = p & 15, b = bh >> 3, hd = bh & 7;
#pragma unroll 1
            for (int e = 0; e < 2; ++e) {
                const int qb = e == 0 ? 31 - s : s, q0 = qb * 256;
                attn_unit<96, 64, true, 128, true>(QRAW + ((size_t)(b * SEQ + q0)) * 768 + hd * 96, 768, KF + (size_t)b * SEQ * 768 + hd * 96, 768, VT + (size_t)(b * 8 + hd) * 64 * SEQ, SEQ,
                                        YB + ((size_t)(b * SEQ + q0)) * 512 + hd * 64, 512, q0, (q0 + 256) / 128, lds, kbound, args.in[17], positions + b * SEQ + q0, QSCALE_MLA);
            }
        }
#endif
#ifndef NO_MEMATT
        for (int p = bx; p < 256; p += G) {
            const int qb = p & 31, hd = (p >> 5) & 3, b = p >> 7, q0 = qb * 256;
            attn_unit<128, 128, false, 64, false>(QM + ((size_t)(b * SEQ + q0)) * 512 + hd * 128, 512, KM + (size_t)b * 256 * 512 + hd * 128, 512, VMT + (size_t)(b * 4 + hd) * 128 * 256, 256,
                                       YC + ((size_t)(b * SEQ + q0)) * 512 + hd * 128, 512, q0, 4, lds, 0.f, args.in[21], nullptr, QSCALE_MEM);
        }
#endif
    }
    SEAM(6);
    if (IN(7)) DUP(7) { unsigned char* ws = opaque_ptr(args.ws);
        pg8::Gemm g{X1B, wGT, T, NGATE, 1024}; GateOrder S; S.base.init(T, 1024, G, bx); EpiGate E{SS1, args.in[8], G0};
        pg8::gemm_phase<EpiGate, GateOrder, true, true>(lds, g, S, E);
    }
    if (IN(8)) DUP(8) { unsigned char* ws = opaque_ptr(args.ws);
        static_assert(B_YB - B_U == 16 * MiB && B_YC - B_YB == 16 * MiB && W_BB - W_BA == MiB && W_BC - W_BB == MiB, "branch operands contiguous");
        int kk = 512; asm volatile("" : "+s"(kk));
        pg8::Gemm g{U, wBA, 3 * T, 3072, kk}; BranchOrder S; S.base.init(T, 1024, G, bx); EpiBranch E{G0, MGO};
        pg8::gemm_phase<EpiBranch, BranchOrder, true, true>(lds, g, S, E);
    }
    SEAM(8);
    if (IN(9)) DUP(9) { unsigned char* ws = opaque_ptr(args.ws); const bool dry = rep_ < ((DUP_MASK >> 9) & 1);
        pg8::Gemm g{MGO, wOUT, T, 1024, 1024}; pg8::StaticOrder S; S.init(T, 1024, G, bx); EpiResid<true, true, false> E{nullptr, X1B, nullptr, X2B, dry ? (float*)(ws + S_DUMMY) : SS2, 1.0f};
        pg8::gemm_phase<EpiResid<true, true, false>, pg8::StaticOrder, true, true>(lds, g, S, E);
    }
    SEAM(9);
    if (IN(10)) DUP(10) { unsigned char* ws = opaque_ptr(args.ws);
        pg8::Gemm g{X2B, wGU2, T, 5632, 1024}; pg8::StaticOrder S; S.init(T, 5632, G, bx); EpiSwiglu<16> E{ACT, SS2};
        pg8::gemm_phase<EpiSwiglu<16>, pg8::StaticOrder, true, true>(lds, g, S, E);
    }
    SEAM(10);
    if (IN(11)) DUP(11) { unsigned char* ws = opaque_ptr(args.ws); const bool dry = rep_ < ((DUP_MASK >> 11) & 1);
        pg8::Gemm g{ACT, wDN2, T, 1024, FF}; pg8::StaticOrder S; S.init(T, 1024, G, bx); EpiResid<false, true, true> E{nullptr, X2B, out, nullptr, nullptr, 0.5f};
        pg8::gemm_phase<EpiResid<false, true, true>, pg8::StaticOrder, true, true>(lds, g, S, E);
    }
#undef IN
#undef SEAM
}

#ifndef N_LAUNCH_SPLIT
#define N_LAUNCH_SPLIT 0
#endif
extern "C" void kernel_launch(void* const* d_in, const int* in_sizes, int n_in, void* d_out, int out_size, void* d_ws, size_t ws_size, hipStream_t stream) {
    static int grid = 0;
    if (grid == 0) {
        if (n_in != 30 || out_size != T * DM || ws_size < WS_NEED) { fprintf(stderr, "kernel_launch: unexpected shapes (n_in %d out %d ws %zu)\n", n_in, out_size, ws_size); grid = -1; return; }
        int dev = 0, cus = 0, per_cu = 0;
        hipGetDevice(&dev); hipDeviceGetAttribute(&cus, hipDeviceAttributeMultiprocessorCount, dev);
        if (hipFuncSetAttribute((const void*)fwd_mega, hipFuncAttributeMaxDynamicSharedMemorySize, LDS_BYTES) != hipSuccess) { fprintf(stderr, "kernel_launch: hipFuncSetAttribute failed\n"); grid = -1; return; }
        if (hipOccupancyMaxActiveBlocksPerMultiprocessor(&per_cu, (const void*)fwd_mega, 512, LDS_BYTES) != hipSuccess || per_cu < 1) { fprintf(stderr, "kernel_launch: occupancy query says %d\n", per_cu); per_cu = 1; }
        (void)hipGetLastError();
        grid = cus * 1;
        if (grid > cus * per_cu) grid = cus * per_cu;
    }
    if (grid < 0) return;
    if (hipMemsetAsync((char*)d_ws + S_BAR, 0, XCD_BAR_WORDS * 4, stream) != hipSuccess) { fprintf(stderr, "kernel_launch: hipMemsetAsync of the barrier words failed\n"); return; }
    Args a{};
    for (int i = 0; i < 30; ++i) a.in[i] = (const float*)d_in[i];
    a.out = (float*)d_out; a.ws = (unsigned char*)d_ws;
#if N_LAUNCH_SPLIT
    for (int p = 0; p < NPH; ++p) { a.ph_lo = p; a.ph_hi = p + 1; void* kargs[] = {&a}; hipError_t e = hipLaunchCooperativeKernel((const void*)fwd_mega, dim3(grid), dim3(512), kargs, LDS_BYTES, stream);
        if (e != hipSuccess) { fprintf(stderr, "launch %d failed: %s\n", p, hipGetErrorString(e)); break; } }
#else
    a.ph_lo = 0; a.ph_hi = NPH; void* kargs[] = {&a};
    hipError_t e = hipLaunchCooperativeKernel((const void*)fwd_mega, dim3(grid), dim3(512), kargs, LDS_BYTES, stream);
    if (e != hipSuccess) fprintf(stderr, "cooperative launch failed: %s (grid %d)\n", hipGetErrorString(e), grid);
#endif
}
```
